# Optimizing an MI355X kernel written in HIP

```python
import jax, jax.numpy as jnp
from jax import lax
import numpy as np

D_MODEL = 1024
BATCH = 16
SEQ = 2048
DEPTH = 1

N_META = 16
GRID_W = 64
NA_HEADS = 8
NA_HEAD_DIM = 64
NA_WIDTH = NA_HEADS * NA_HEAD_DIM
NA_KH_MAX = 8
NA_KW = 16
GLA_HEADS = 4
GLA_DK = 64
GLA_DV = 128
GLA_KEY_WIDTH = GLA_HEADS * GLA_DK
GLA_VAL_WIDTH = GLA_HEADS * GLA_DV
GLA_GATE_RANK = 16
GLA_GATE_TAU = 16.0
GLA_CHUNK = 64
MIX_WIDTH = NA_WIDTH + GLA_VAL_WIDTH
D_FF = -(-8 * D_MODEL // (3 * 256)) * 256
RMS_EPS = 1e-6
NEG_INF = -1e30
IN_SPLIT_SIZES = (NA_WIDTH, NA_WIDTH, NA_WIDTH,
                  GLA_KEY_WIDTH, GLA_KEY_WIDTH,
                  GLA_VAL_WIDTH, GLA_VAL_WIDTH,
                  GLA_GATE_RANK, GLA_GATE_RANK)
IN_WIDTH = sum(IN_SPLIT_SIZES)

kernel_name = "hybrid_na_gla_bidir_block"


def rms_norm(x, gain, eps=RMS_EPS):
    xf = x.astype(jnp.float32)
    xf = xf * lax.rsqrt(jnp.mean(xf * xf, axis=-1, keepdims=True) + eps)
    return (xf * gain.astype(jnp.float32)).astype(x.dtype)


def neighbourhood_attention(q, k, v, rpb, meta_bias):
    B, L, H, d = q.shape
    N = L - N_META
    rows = N // GRID_W
    kh = min(NA_KH_MAX, rows)
    q = q * (d ** -0.5)
    qm, qg = q[:, :N_META], q[:, N_META:]
    km, kg = k[:, :N_META], k[:, N_META:]
    vm, vg = v[:, :N_META], v[:, N_META:]
    qg = qg.reshape(B, rows, GRID_W, H, d).transpose(1, 0, 3, 2, 4)
    kg = kg.reshape(B, rows, GRID_W, H, d).transpose(0, 3, 1, 2, 4)
    vg = vg.reshape(B, rows, GRID_W, H, d).transpose(0, 3, 1, 2, 4)
    km_h = km.transpose(0, 2, 1, 3)
    vm_h = vm.transpose(0, 2, 1, 3)

    cols = jnp.arange(GRID_W)
    col_start = jnp.clip(cols - NA_KW // 2, 0, GRID_W - NA_KW)
    col_valid = (cols[None, :] >= col_start[:, None]) & (cols[None, :] < col_start[:, None] + NA_KW)
    dc_idx = jnp.clip(cols[None, :] - cols[:, None], -(NA_KW - 1), NA_KW - 1) + (NA_KW - 1)
    row_ids = jnp.arange(rows)
    row_start = jnp.clip(row_ids - kh // 2, 0, rows - kh)

    def row_block(args):
        i, s, q_i = args
        k_win = lax.dynamic_slice_in_dim(kg, s, kh, axis=2)
        v_win = lax.dynamic_slice_in_dim(vg, s, kh, axis=2)
        dr_idx = s + jnp.arange(kh) - i + (NA_KH_MAX - 1)
        bias = rpb[:, dr_idx[:, None, None], dc_idx[None]]
        s_win = jnp.einsum('bhqd,bhrkd->bhqrk', q_i, k_win).astype(jnp.float32)
        s_win = s_win + bias.transpose(0, 2, 1, 3)[None].astype(jnp.float32)
        s_win = jnp.where(col_valid[:, None, :], s_win, NEG_INF)
        s_meta = jnp.einsum('bhqd,bhmd->bhqm', q_i, km_h).astype(jnp.float32)
        s_meta = s_meta + meta_bias[None, :, None, :].astype(jnp.float32)
        scores = jnp.concatenate([s_win.reshape(B, H, GRID_W, kh * GRID_W), s_meta], axis=-1)
        p = jax.nn.softmax(scores, axis=-1).astype(v.dtype)
        p_win = p[..., :kh * GRID_W].reshape(B, H, GRID_W, kh, GRID_W)
        p_meta = p[..., kh * GRID_W:]
        return (jnp.einsum('bhqrk,bhrkd->bhqd', p_win, v_win)
                + jnp.einsum('bhqm,bhmd->bhqd', p_meta, vm_h))

    out_g = lax.map(row_block, (row_ids, row_start, qg))
    out_g = out_g.transpose(1, 0, 3, 2, 4).reshape(B, N, H * d)
    s_mm = jnp.einsum('bmhd,bnhd->bhmn', qm, km).astype(jnp.float32) + meta_bias[None, :, None, :].astype(jnp.float32)
    p_mm = jax.nn.softmax(s_mm, axis=-1).astype(v.dtype)
    out_m = jnp.einsum('bhmn,bnhd->bmhd', p_mm, vm).reshape(B, N_META, H * d)
    return jnp.concatenate([out_m, out_g], axis=1)


def gla_chunked(q, k, v, g):
    B, H, T, dk = q.shape
    dv = v.shape[-1]
    nc = T // GLA_CHUNK
    qf = q.astype(jnp.float32).reshape(B, H, nc, GLA_CHUNK, dk)
    kf = k.astype(jnp.float32).reshape(B, H, nc, GLA_CHUNK, dk)
    vf = v.astype(jnp.float32).reshape(B, H, nc, GLA_CHUNK, dv)
    b = jnp.cumsum(g.astype(jnp.float32).reshape(B, H, nc, GLA_CHUNK, dk), axis=3)
    b_last = b[:, :, :, -1:]
    q_e = qf * jnp.exp(b)
    k_e = kf * jnp.exp(-b)
    k_d = kf * jnp.exp(b_last - b)
    causal = jnp.tril(jnp.ones((GLA_CHUNK, GLA_CHUNK), dtype=bool))
    a = jnp.where(causal, jnp.einsum('bhnik,bhnjk->bhnij', q_e, k_e), 0.0)
    o_intra = jnp.einsum('bhnij,bhnjv->bhniv', a, vf)
    kv = jnp.einsum('bhnjk,bhnjv->bhnkv', k_d, vf)
    decay = jnp.exp(b_last[:, :, :, 0])

    def step(state, inp):
        kv_n, dec_n = inp
        return dec_n[..., None] * state + kv_n, state

    init = jnp.zeros((B, H, dk, dv), jnp.float32)
    _, s_prev = lax.scan(step, init, (kv.transpose(2, 0, 1, 3, 4), decay.transpose(2, 0, 1, 3)))
    o_inter = jnp.einsum('bhnik,nbhkv->bhniv', q_e, s_prev)
    return (o_intra + o_inter).reshape(B, H, T, dv).astype(v.dtype)


def gla_bidirectional(q, k, v, r, gate_f_low, gate_b_low, w_gate_up_f, b_gate_f, w_gate_up_b, b_gate_b, norm_gain):
    B, L, _ = q.shape
    pad = (-N_META) % GLA_CHUNK
    g_f = jax.nn.log_sigmoid((gate_f_low @ w_gate_up_f + b_gate_f).astype(jnp.float32)) / GLA_GATE_TAU
    g_b = jax.nn.log_sigmoid((gate_b_low @ w_gate_up_b + b_gate_b).astype(jnp.float32)) / GLA_GATE_TAU

    def heads(a, dh):
        a = a.reshape(B, L, GLA_HEADS, dh).transpose(0, 2, 1, 3)
        return jnp.pad(a, ((0, 0), (0, 0), (pad, 0), (0, 0)))

    qh = heads(q * (GLA_DK ** -0.5), GLA_DK)
    kh = heads(k, GLA_DK)
    vh = heads(v, GLA_DV)
    gfh = heads(g_f, GLA_DK)
    gbh = heads(g_b, GLA_DK)
    flip = lambda a: jnp.flip(a, axis=2)
    o_fwd = gla_chunked(qh, kh, vh, gfh)
    o_bwd = flip(gla_chunked(flip(qh), flip(kh), flip(vh), flip(gbh)))
    o = (o_fwd + o_bwd)[:, :, pad:].transpose(0, 2, 1, 3)
    o = rms_norm(o, norm_gain).reshape(B, L, GLA_VAL_WIDTH)
    return o * jax.nn.silu(r)


def setup_inputs(seed: int = 0) -> dict:
    key = jax.random.key(seed)
    ks = jax.random.split(key, 20)
    f32 = jnp.float32
    nrm = lambda k, shape, scale: jax.random.normal(k, shape, f32) * scale
    gains = lambda k, shape: 1.0 + 0.05 * jax.random.normal(k, shape, f32)
    return {
        "x": jax.random.normal(ks[0], (BATCH, SEQ, D_MODEL), f32),
        "meta_tokens": nrm(ks[1], (N_META, D_MODEL), 1.0),
        "norm_mix_gain": gains(ks[2], (DEPTH, D_MODEL)),
        "w_in": nrm(ks[3], (DEPTH, D_MODEL, IN_WIDTH), D_MODEL ** -0.5),
        "rpb": nrm(ks[4], (DEPTH, NA_HEADS, 2 * NA_KH_MAX - 1, 2 * NA_KW - 1), 0.1),
        "meta_bias": nrm(ks[5], (DEPTH, NA_HEADS, N_META), 0.1),
        "w_gate_up_fwd": nrm(ks[6], (DEPTH, GLA_GATE_RANK, GLA_KEY_WIDTH), GLA_GATE_RANK ** -0.5),
        "b_gate_fwd": nrm(ks[7], (DEPTH, GLA_KEY_WIDTH), 0.1),
        "w_gate_up_bwd": nrm(ks[8], (DEPTH, GLA_GATE_RANK, GLA_KEY_WIDTH), GLA_GATE_RANK ** -0.5),
        "b_gate_bwd": nrm(ks[9], (DEPTH, GLA_KEY_WIDTH), 0.1),
        "gla_norm_gain": gains(ks[10], (DEPTH, GLA_DV)),
        "w_out": nrm(ks[11], (DEPTH, MIX_WIDTH, D_MODEL), MIX_WIDTH ** -0.5),
        "norm_ffn_gain": gains(ks[12], (DEPTH, D_MODEL)),
        "w_ffn_gate": nrm(ks[13], (DEPTH, D_MODEL, D_FF), D_MODEL ** -0.5),
        "w_ffn_up": nrm(ks[14], (DEPTH, D_MODEL, D_FF), D_MODEL ** -0.5),
        "w_ffn_down": nrm(ks[15], (DEPTH, D_FF, D_MODEL), D_FF ** -0.5),
        "norm_final_gain": gains(ks[16], (D_MODEL,)),
    }


def reference(x, meta_tokens, norm_mix_gain, w_in, rpb, meta_bias, w_gate_up_fwd, b_gate_fwd,
              w_gate_up_bwd, b_gate_bwd, gla_norm_gain, w_out, norm_ffn_gain, w_ffn_gate,
              w_ffn_up, w_ffn_down, norm_final_gain):
    B = x.shape[0]
    meta = jnp.broadcast_to(meta_tokens.astype(x.dtype)[None], (B, N_META, D_MODEL))
    h = jnp.concatenate([meta, x], axis=1)
    L = h.shape[1]
    split_points = [int(s) for s in np.cumsum(IN_SPLIT_SIZES)[:-1]]
    for layer in range(DEPTH):
        xn = rms_norm(h, norm_mix_gain[layer])
        proj = xn @ w_in[layer]
        na_q, na_k, na_v, g_q, g_k, g_v, g_r, g_fl, g_bl = jnp.split(proj, split_points, axis=-1)
        na_heads = lambda a: a.reshape(B, L, NA_HEADS, NA_HEAD_DIM)
        na_out = neighbourhood_attention(na_heads(na_q), na_heads(na_k), na_heads(na_v),
                                         rpb[layer], meta_bias[layer])
        gla_out = gla_bidirectional(g_q, g_k, g_v, g_r, g_fl, g_bl,
                                    w_gate_up_fwd[layer], b_gate_fwd[layer],
                                    w_gate_up_bwd[layer], b_gate_bwd[layer],
                                    gla_norm_gain[layer])
        h = h + jnp.concatenate([na_out, gla_out], axis=-1) @ w_out[layer]
        hn = rms_norm(h, norm_ffn_gain[layer])
        h = h + (jax.nn.silu(hn @ w_ffn_gate[layer]) * (hn @ w_ffn_up[layer])) @ w_ffn_down[layer]
    h = rms_norm(h, norm_final_gain)
    return h[:, N_META:]
```

```cpp
#include <hip/hip_runtime.h>
#include <hip/hip_cooperative_groups.h>
#include <cstdio>
#include <cstdint>
namespace cg = cooperative_groups;

#ifndef MK_N_LAUNCHES
#define MK_N_LAUNCHES 1
#endif

namespace pg8 {
#define PG8_LAS __attribute__((address_space(3)))
typedef unsigned short bf16_t;
typedef short bf16x8 __attribute__((ext_vector_type(8)));
typedef float f32x4 __attribute__((ext_vector_type(4)));
typedef unsigned u32x4 __attribute__((ext_vector_type(4)));
constexpr int BM = 256, BK = 64, HALF = 128, HTB = HALF * BK * 2  , STAGE_BYTES = 8 * HTB, NXCD = 8, WGM = 8;

__host__ __device__ __forceinline__ int lds_byte(int r, int c) { const int st = (r >> 4) * 2 + (c >> 5), rr = r & 15, cc = c & 31, ob = rr * 64 + cc * 2; return st * 1024 + (ob ^ (((ob >> 9) & 1) << 5)); }
__host__ __device__ __forceinline__ void stage_rc(int b, int& R, int& C) { const int st = b / 1024, sb = b % 1024, swz = sb ^ (((sb >> 9) & 1) << 5); R = (st >> 1) * 16 + swz / 64; C = (st & 1) * 32 + (swz % 64) / 2; }
__host__ __device__ __forceinline__ int perm32(int rho) { const int n = rho >> 4, i = rho & 15; return 8 * (i >> 2) + 4 * n + (i & 3); }

struct Unit { int pm, pn; };
struct Gemm { const bf16_t* A; const bf16_t* Bt; int M, N, K; };

struct StaticOrder {
    int nM, nN, nwg, G, c;
    __host__ __device__ void init(int M, int N, int G_, int c_) { nM = M / BM; nN = N / BM; nwg = nM * nN; G = G_; c = c_; }
    __host__ __device__ bool next(int i, Unit& u) const {
        const long L = (long)i * G + c; if (L >= nwg) return false;
        int wgid = (int)L; { const int q = nwg / NXCD, r = nwg % NXCD, xcd = wgid % NXCD, off = wgid / NXCD; wgid = (xcd < r ? xcd * (q + 1) : r * (q + 1) + (xcd - r) * q) + off; }
        const int nig = WGM * nN, gid = wgid / nig, fm = gid * WGM, gsz = (nM - fm) < WGM ? (nM - fm) : WGM;
        u.pm = fm + ((wgid % nig) % gsz); u.pn = (wgid % nig) / gsz; return true;
    }
    __device__ __forceinline__ void a_ready(const Unit&) const {}
    __device__ __forceinline__ void done(const Unit&) const {}
};

typedef float f32x2_t __attribute__((ext_vector_type(2))); typedef __bf16 bf16x2_t __attribute__((ext_vector_type(2)));
__device__ __forceinline__ unsigned cvtpk(float lo, float hi) { f32x2_t v = {lo, hi}; bf16x2_t b = __builtin_convertvector(v, bf16x2_t); return __builtin_bit_cast(unsigned, b); }
__device__ __forceinline__ u32x4 pack8(const f32x4 a, const f32x4 b) { u32x4 w; w.x = cvtpk(a[0], a[1]); w.y = cvtpk(a[2], a[3]); w.z = cvtpk(b[0], b[1]); w.w = cvtpk(b[2], b[3]); return w; }

constexpr int NTT = 129;
constexpr int PROJ_P = 2048;
constexpr int VT_P = 33024;

struct EpiProj {
    static constexpr bool PERM = true, AFTER_DRAIN = false;
    bf16_t* PROJ; float* GATE; bf16_t* VT;
    __device__ __forceinline__ void operator()(const f32x4 (&acc)[2][2][4][2], const Unit& u, int wr, int wc, int fr, int fq) const {
        if (u.pm < NTT) {
            const int wt = u.pn - NTT; const int row0 = u.pm * BM + wr * 64 + fr;
            if (wt < 8) {
                const int col0 = wt * BM + wc * 32 + 8 * fq;
#pragma unroll
                for (int ai = 0; ai < 2; ++ai)
#pragma unroll
                    for (int m = 0; m < 4; ++m) { bf16_t* rowp = PROJ + (size_t)(row0 + ai * HALF + m * 16) * PROJ_P + col0;
#pragma unroll
                        for (int bj = 0; bj < 2; ++bj) *(u32x4*)(rowp + bj * HALF) = pack8(acc[ai][bj][m][0], acc[ai][bj][m][1]); }
            } else if (wc == 0) {
#pragma unroll
                for (int ai = 0; ai < 2; ++ai)
#pragma unroll
                    for (int m = 0; m < 4; ++m) { float* rowp = GATE + (size_t)(row0 + ai * HALF + m * 16) * 32 + 8 * fq;
                        *(f32x4*)rowp = acc[ai][0][m][0]; *(f32x4*)(rowp + 4) = acc[ai][0][m][1]; }
            }
        } else {
            const int wt = u.pm - NTT - 9; const int row0 = wt * BM + wr * 64 + fr; const int col0 = u.pn * BM + wc * 32 + 8 * fq;
#pragma unroll
            for (int ai = 0; ai < 2; ++ai)
#pragma unroll
                for (int m = 0; m < 4; ++m) { bf16_t* rowp = VT + (size_t)(row0 + ai * HALF + m * 16) * VT_P + col0;
#pragma unroll
                    for (int bj = 0; bj < 2; ++bj) *(u32x4*)(rowp + bj * HALF) = pack8(acc[ai][bj][m][0], acc[ai][bj][m][1]); }
        }
    }
};
struct EpiRes1 {
    static constexpr bool PERM = true, AFTER_DRAIN = false;
    const float* X; float* H1; bf16_t* HB; float* SS;
    __device__ __forceinline__ void operator()(const f32x4 (&acc)[2][2][4][2], const Unit& u, int wr, int wc, int fr, int fq) const {
        const int row0 = u.pm * BM + wr * 64 + fr, col0 = u.pn * BM + wc * 32 + 8 * fq;
#pragma unroll
        for (int ai = 0; ai < 2; ++ai)
#pragma unroll
            for (int m = 0; m < 4; ++m) { const int r = row0 + ai * HALF + m * 16; const size_t off = (size_t)r * 1024 + col0; float ss = 0.f;
#pragma unroll
                for (int bj = 0; bj < 2; ++bj) { const f32x4 x0 = *(const f32x4*)(X + off + bj * HALF), x1 = *(const f32x4*)(X + off + bj * HALF + 4);
                    const f32x4 v0 = acc[ai][bj][m][0] + x0, v1 = acc[ai][bj][m][1] + x1;
                    *(f32x4*)(H1 + off + bj * HALF) = v0; *(f32x4*)(H1 + off + bj * HALF + 4) = v1; *(u32x4*)(HB + off + bj * HALF) = pack8(v0, v1);
                    ss += (v0[0] * v0[0] + v0[1] * v0[1]) + (v0[2] * v0[2] + v0[3] * v0[3]) + (v1[0] * v1[0] + v1[1] * v1[1]) + (v1[2] * v1[2] + v1[3] * v1[3]); }
                ss += __shfl_xor(ss, 16); ss += __shfl_xor(ss, 32);
                if (fq == 0) atomicAdd(SS + r, ss); }
    }
};
struct EpiSwiglu {
    static constexpr bool PERM = true, AFTER_DRAIN = false;
    bf16_t* F; const float* SS;
    __device__ __forceinline__ void operator()(const f32x4 (&acc)[2][2][4][2], const Unit& u, int wr, int wc, int fr, int fq) const {
        const int row0 = u.pm * BM + wr * 64 + fr, col0 = u.pn * HALF + wc * 32 + 8 * fq;
#pragma unroll
        for (int ai = 0; ai < 2; ++ai)
#pragma unroll
            for (int m = 0; m < 4; ++m) { const int r = row0 + ai * HALF + m * 16; const float rstd = 1.0f / sqrtf(SS[r] * (1.0f / 1024.0f) + 1e-6f);
                f32x4 o[2];
#pragma unroll
                for (int n = 0; n < 2; ++n) { const f32x4 g = acc[ai][0][m][n] * rstd, up = acc[ai][1][m][n] * rstd;
#pragma unroll
                    for (int e = 0; e < 4; ++e) o[n][e] = g[e] * __builtin_amdgcn_rcpf(1.0f + __builtin_amdgcn_exp2f(-1.4426950408889634f * g[e])) * up[e]; }
                *(u32x4*)(F + (size_t)r * 2816 + col0) = pack8(o[0], o[1]); }
    }
};
struct EpiRes2 {
    static constexpr bool PERM = true, AFTER_DRAIN = false;
    float* H; float* SS;
    __device__ __forceinline__ void operator()(const f32x4 (&acc)[2][2][4][2], const Unit& u, int wr, int wc, int fr, int fq) const {
        const int row0 = u.pm * BM + wr * 64 + fr, col0 = u.pn * BM + wc * 32 + 8 * fq;
#pragma unroll
        for (int ai = 0; ai < 2; ++ai)
#pragma unroll
            for (int m = 0; m < 4; ++m) { const int r = row0 + ai * HALF + m * 16; const size_t off = (size_t)r * 1024 + col0; float ss = 0.f;
#pragma unroll
                for (int bj = 0; bj < 2; ++bj) { const f32x4 x0 = *(const f32x4*)(H + off + bj * HALF), x1 = *(const f32x4*)(H + off + bj * HALF + 4);
                    const f32x4 v0 = acc[ai][bj][m][0] + x0, v1 = acc[ai][bj][m][1] + x1;
                    *(f32x4*)(H + off + bj * HALF) = v0; *(f32x4*)(H + off + bj * HALF + 4) = v1;
                    ss += (v0[0] * v0[0] + v0[1] * v0[1]) + (v0[2] * v0[2] + v0[3] * v0[3]) + (v1[0] * v1[0] + v1[1] * v1[1]) + (v1[2] * v1[2] + v1[3] * v1[3]); }
                ss += __shfl_xor(ss, 16); ss += __shfl_xor(ss, 32);
                if (fq == 0) atomicAdd(SS + r, ss); }
    }
};
struct TileOrder {
    int nM, nN, nwg;
    __device__ void init(int nM_, int nN_) { nM = nM_; nN = nN_; nwg = nM * nN; }
    __device__ void map(int L, int& pm, int& pn) const {
        int wgid = L; { const int q = nwg / NXCD, r = nwg % NXCD, xcd = wgid % NXCD, off = wgid / NXCD; wgid = (xcd < r ? xcd * (q + 1) : r * (q + 1) + (xcd - r) * q) + off; }
        const int nig = WGM * nN, gid = wgid / nig, fm = gid * WGM, gsz = (nM - fm) < WGM ? (nM - fm) : WGM;
        pm = fm + ((wgid % nig) % gsz); pn = (wgid % nig) / gsz;
    }
};
struct SchedP1 {
    TileOrder a, b; int G, c;
    __device__ void init(int G_, int c_) { a.init(NTT, 9); b.init(4, NTT); G = G_; c = c_; }
    __device__ bool next(int i, Unit& u) const {
        const long L = (long)i * G + c; if (L >= a.nwg + b.nwg) return false;
        int pm, pn;
        if (L < a.nwg) { a.map((int)L, pm, pn); u.pm = pm; u.pn = NTT + pn; }
        else { b.map((int)L - a.nwg, pm, pn); u.pm = NTT + 9 + pm; u.pn = pn; }
        return true;
    }
    __device__ __forceinline__ void a_ready(const Unit&) const {}
    __device__ __forceinline__ void done(const Unit&) const {}
};
template <class Epi, class Sched, bool ALIGN_EPI = false, bool SP2 = false>
__device__ __forceinline__ void gemm_phase(PG8_LAS unsigned char* lds, const Gemm g, const Sched& S, const Epi& E, const int tid) {
    const int wid = __builtin_amdgcn_readfirstlane(tid >> 6), lane = tid & 63, wr = wid >> 2, wc = wid & 3, fr = lane & 15, fq = lane >> 4;
    const int K = g.K, nt = K / BK;
    unsigned voffA[2], voffB[2];
#pragma unroll
    for (int i = 0; i < 2; ++i) { int R, C; stage_rc(tid * 16 + i * 8192, R, C); const int Rb = Epi::PERM ? ((R & ~31) + perm32(R & 31)) : R;
        voffA[i] = (unsigned)(R * K + C) * 2u; voffB[i] = (unsigned)(Rb * K + C) * 2u; }
    const size_t kstep = (size_t)(BK * 2);
    const size_t hstep = (size_t)HALF * K * 2;
    const size_t tstep = 2 * hstep;
    const unsigned ldsw = (unsigned)wid * 1024u;
    const int aoff = lds_byte(wr * 64 + fr, fq * 8), boff = lds_byte(wc * 32 + fr, fq * 8);
#define PG8_SA(b, h) (((b) * 2 + (h)) * HTB)
#define PG8_SB(b, h) ((4 + (b) * 2 + (h)) * HTB)
#define PG8_STAGE(bufoff, gbase, voff) do { _Pragma("unroll") for (int _i = 0; _i < 2; ++_i) \
        __builtin_amdgcn_global_load_lds((const unsigned*)((const char*)(gbase) + (voff)[_i]), (PG8_LAS unsigned*)(lds + (bufoff) + ldsw + _i * 8192), 16, 0, 0); } while (0)
#define PG8_LDA(dst, b, h) do { _Pragma("unroll") for (int m = 0; m < 4; ++m) _Pragma("unroll") for (int k = 0; k < 2; ++k) dst[m][k] = *(const PG8_LAS bf16x8*)(lds + PG8_SA(b, h) + aoff + m * 2048 + k * 1024); } while (0)
#define PG8_LDB(dst, b, h) do { _Pragma("unroll") for (int n = 0; n < 2; ++n) _Pragma("unroll") for (int k = 0; k < 2; ++k) dst[n][k] = *(const PG8_LAS bf16x8*)(lds + PG8_SB(b, h) + boff + n * 2048 + k * 1024); } while (0)
#define PG8_MMA(ai, bj, At, Bt) do { __builtin_amdgcn_s_setprio(1); _Pragma("unroll") for (int m = 0; m < 4; ++m) _Pragma("unroll") for (int n = 0; n < 2; ++n) _Pragma("unroll") for (int k = 0; k < 2; ++k) \
        acc[ai][bj][m][n] = __builtin_amdgcn_mfma_f32_16x16x32_bf16(Bt[n][k], At[m][k], acc[ai][bj][m][n], 0, 0, 0); __builtin_amdgcn_s_setprio(0); } while (0)
#define PG8_WAIT_V(n) asm volatile("s_waitcnt vmcnt(" #n ")" ::: "memory")
#define PG8_WAIT_L(n) asm volatile("s_waitcnt lgkmcnt(" #n ")" ::: "memory")
#define PG8_BAR __builtin_amdgcn_s_barrier()
#define PG8_SCHED __builtin_amdgcn_sched_barrier(0)
    Unit cur, nxt; int ui = 0;
    if (!S.next(0, cur)) return;
    f32x4 acc[2][2][4][2];
#pragma unroll
    for (int a = 0; a < 2; ++a)
#pragma unroll
        for (int b = 0; b < 2; ++b)
#pragma unroll
            for (int m = 0; m < 4; ++m)
#pragma unroll
                for (int n = 0; n < 2; ++n) acc[a][b][m][n] = (f32x4){0.f, 0.f, 0.f, 0.f};
    bf16x8 At[4][2], B0[2][2], B1[2][2];
    const char* cA = (const char*)g.A + (size_t)cur.pm * tstep; const char* cB = (const char*)g.Bt + (size_t)cur.pn * tstep;
    S.a_ready(cur);
    if constexpr (SP2) {
        PG8_STAGE(PG8_SB(0, 0), cB, voffB); PG8_STAGE(PG8_SB(0, 1), cB + hstep, voffB); PG8_STAGE(PG8_SA(0, 0), cA, voffA); PG8_STAGE(PG8_SA(0, 1), cA + hstep, voffA);
        if (wr == 1) PG8_BAR;
        PG8_WAIT_V(2); PG8_BAR;
        PG8_STAGE(PG8_SB(1, 0), cB + kstep, voffB); PG8_STAGE(PG8_SA(1, 0), cA + kstep, voffA); PG8_STAGE(PG8_SB(1, 1), cB + hstep + kstep, voffB);
        PG8_WAIT_V(6); PG8_BAR;
    } else {
        PG8_STAGE(PG8_SB(0, 0), cB, voffB); PG8_STAGE(PG8_SA(0, 0), cA, voffA); PG8_STAGE(PG8_SB(0, 1), cB + hstep, voffB); PG8_STAGE(PG8_SA(0, 1), cA + hstep, voffA);
        if (wr == 1) PG8_BAR;
        PG8_WAIT_V(4); PG8_BAR;
        PG8_STAGE(PG8_SB(1, 0), cB + kstep, voffB); PG8_STAGE(PG8_SA(1, 0), cA + kstep, voffA); PG8_STAGE(PG8_SB(1, 1), cB + hstep + kstep, voffB);
        PG8_WAIT_V(6); PG8_BAR;
    }
    for (;;) {
        const bool has_next = S.next(ui + 1, nxt);
        const char* nA = has_next ? (const char*)g.A + (size_t)nxt.pm * tstep : cA; const char* nB = has_next ? (const char*)g.Bt + (size_t)nxt.pn * tstep : cB;
        for (int t = 0; t < nt; t += 2) {
            const bool last = (t == nt - 2);
            const char* a1 = cA + (size_t)(t + 1) * kstep;
            const char* a2 = last ? nA : cA + (size_t)(t + 2) * kstep; const char* b2 = last ? nB : cB + (size_t)(t + 2) * kstep;
            const char* a3 = a2 + kstep; const char* b3 = b2 + kstep;
            if (last && has_next) S.a_ready(nxt);
            if constexpr (SP2) {
            PG8_LDB(B0, 0, 0); PG8_LDB(B1, 0, 1); PG8_SCHED; PG8_LDA(At, 0, 0); PG8_STAGE(PG8_SA(1, 1), a1 + hstep, voffA);
            PG8_WAIT_V(8); PG8_WAIT_L(0); PG8_BAR; PG8_MMA(0, 0, At, B0); PG8_MMA(0, 1, At, B1); PG8_BAR; PG8_SCHED;
            PG8_LDA(At, 0, 1); PG8_STAGE(PG8_SB(0, 0), b2, voffB); PG8_STAGE(PG8_SB(0, 1), b2 + hstep, voffB); PG8_STAGE(PG8_SA(0, 0), a2, voffA);
            PG8_WAIT_V(8); PG8_WAIT_L(0); PG8_BAR; PG8_MMA(1, 0, At, B0); PG8_MMA(1, 1, At, B1); PG8_BAR; PG8_SCHED;
            PG8_LDB(B0, 1, 0); PG8_LDB(B1, 1, 1); PG8_SCHED; PG8_LDA(At, 1, 0); PG8_STAGE(PG8_SA(0, 1), a2 + hstep, voffA);
            PG8_WAIT_V(8); PG8_WAIT_L(0); PG8_BAR; PG8_MMA(0, 0, At, B0); PG8_MMA(0, 1, At, B1); PG8_BAR; PG8_SCHED;
            PG8_LDA(At, 1, 1); PG8_STAGE(PG8_SB(1, 0), b3, voffB); PG8_STAGE(PG8_SB(1, 1), b3 + hstep, voffB); PG8_STAGE(PG8_SA(1, 0), a3, voffA);
            PG8_WAIT_V(8); PG8_WAIT_L(0); PG8_BAR; PG8_MMA(1, 0, At, B0); PG8_MMA(1, 1, At, B1); PG8_BAR; PG8_SCHED;
            } else {
            PG8_LDB(B0, 0, 0); PG8_SCHED; PG8_LDA(At, 0, 0); PG8_STAGE(PG8_SA(1, 1), a1 + hstep, voffA);
            PG8_WAIT_L(8); PG8_BAR; PG8_WAIT_L(0); PG8_MMA(0, 0, At, B0); PG8_BAR; PG8_SCHED;
            PG8_LDB(B1, 0, 1); PG8_STAGE(PG8_SB(0, 0), b2, voffB);
            PG8_BAR; PG8_WAIT_L(0); PG8_MMA(0, 1, At, B1); PG8_BAR;
            PG8_LDA(At, 0, 1); PG8_STAGE(PG8_SA(0, 0), a2, voffA);
            PG8_BAR; PG8_WAIT_L(0); PG8_MMA(1, 0, At, B0); PG8_BAR; PG8_SCHED;
            PG8_STAGE(PG8_SB(0, 1), b2 + hstep, voffB);
            PG8_WAIT_V(6); PG8_BAR; PG8_MMA(1, 1, At, B1); PG8_BAR;
            PG8_LDB(B0, 1, 0); PG8_SCHED; PG8_LDA(At, 1, 0); PG8_STAGE(PG8_SA(0, 1), a2 + hstep, voffA);
            PG8_WAIT_L(8); PG8_BAR; PG8_WAIT_L(0); PG8_MMA(0, 0, At, B0); PG8_BAR; PG8_SCHED;
            PG8_LDB(B1, 1, 1); PG8_STAGE(PG8_SB(1, 0), b3, voffB);
            PG8_BAR; PG8_WAIT_L(0); PG8_MMA(0, 1, At, B1); PG8_BAR;
            PG8_LDA(At, 1, 1); PG8_STAGE(PG8_SA(1, 0), a3, voffA);
            PG8_BAR; PG8_WAIT_L(0); PG8_MMA(1, 0, At, B0); PG8_BAR; PG8_SCHED;
            PG8_STAGE(PG8_SB(1, 1), b3 + hstep, voffB);
            PG8_WAIT_V(6); PG8_BAR; PG8_MMA(1, 1, At, B1); PG8_BAR;
            }
        }
        if constexpr (ALIGN_EPI) { if (wr == 0) PG8_BAR; }
        if constexpr (!Epi::AFTER_DRAIN) { E(acc, cur, wr, wc, fr, fq); S.done(cur); }
        if (!has_next) break;
#pragma unroll
        for (int a = 0; a < 2; ++a)
#pragma unroll
            for (int b = 0; b < 2; ++b)
#pragma unroll
                for (int m = 0; m < 4; ++m)
#pragma unroll
                    for (int n = 0; n < 2; ++n) acc[a][b][m][n] = (f32x4){0.f, 0.f, 0.f, 0.f};
        cur = nxt; cA = nA; cB = nB; ++ui;
        if constexpr (ALIGN_EPI) { if (wr == 1) PG8_BAR; }
    }
    PG8_WAIT_V(0);
    if constexpr (!ALIGN_EPI) { if (wr == 0) PG8_BAR; }
    PG8_BAR;
    if constexpr (Epi::AFTER_DRAIN) { E.fused(acc, cur, wr, wc, fr, fq, lds, wid, lane); S.done(cur); }
#undef PG8_SA
#undef PG8_SB
#undef PG8_STAGE
#undef PG8_LDA
#undef PG8_LDB
#undef PG8_MMA
#undef PG8_WAIT_V
#undef PG8_WAIT_L
#undef PG8_BAR
#undef PG8_SCHED
}
}

constexpr int NWAVES = 8;
constexpr int DM = 1024, NBATCH = 16, SEQ = 2048, MTOK = NBATCH * SEQ, MROWS = 33024, META_ROW0 = 32768;
constexpr int DFF = 2816, WIN_ROWS = 3328;
constexpr float RMS_EPS = 1e-6f;
constexpr float LOG2E = 1.4426950408889634f;
using pg8::PROJ_P; using pg8::VT_P;
constexpr int PC_NAQ = 0, PC_NAK = 512, PC_GQ = 1024, PC_GK = 1280, PC_GR = 1536;
constexpr size_t WS_XN = 0;
constexpr size_t WS_WIN = WS_XN + (size_t)MROWS * DM * 2;
constexpr size_t WS_WOUT = WS_WIN + (size_t)WIN_ROWS * DM * 2;
constexpr size_t WS_WGU = WS_WOUT + (size_t)DM * DM * 2;
constexpr size_t WS_WDN = WS_WGU + (size_t)2 * DFF * DM * 2;
constexpr size_t WS_SS1 = WS_WDN + (size_t)DM * DFF * 2;
constexpr size_t WS_SS2 = WS_SS1 + (size_t)MTOK * 4;
constexpr size_t WS_CTR = WS_SS2 + (size_t)MTOK * 4;
constexpr size_t WS_GATE = WS_CTR + 256;
constexpr size_t WS_OG = WS_GATE + (size_t)MROWS * 32 * 4;
constexpr size_t WS_MIX = WS_OG + (size_t)2 * MTOK * 512 * 2;
constexpr size_t WS_PROJ = WS_MIX + (size_t)MTOK * DM * 2;
constexpr size_t WS_VT = WS_PROJ + (size_t)MROWS * PROJ_P * 2;
constexpr size_t WS_F = WS_PROJ;
constexpr size_t WS_GQK = WS_VT + (size_t)1024 * VT_P * 2;
constexpr size_t WS_END = WS_GQK + (size_t)128 * 33 * 16384;
constexpr size_t WS_GKD = WS_XN;
constexpr size_t WS_GDEC = WS_GKD + (size_t)128 * 33 * 8192;
static_assert(WS_F + (size_t)MTOK * DFF * 2 <= WS_GQK, "F overlay fits");
static_assert(WS_GDEC + (size_t)128 * 33 * 256 <= WS_WIN, "GLA prep overlay fits in XN");
static_assert(WS_WIN % 16 == 0 && WS_GATE % 16 == 0 && WS_OG % 16 == 0 && WS_PROJ % 16 == 0 && WS_VT % 16 == 0, "alignment");

constexpr int LDS_BYTES = 163840;
#define LAS __attribute__((address_space(3)))
typedef unsigned short bf16;
typedef unsigned v4u __attribute__((ext_vector_type(4)));
typedef unsigned v2u __attribute__((ext_vector_type(2)));
typedef float f32x4 __attribute__((ext_vector_type(4)));
typedef short bf16x8 __attribute__((ext_vector_type(8)));
using pg8::cvtpk;
__device__ __forceinline__ float bf2f(unsigned short x) { return __uint_as_float((unsigned)x << 16); }
#define MFMA16(a, b, c) __builtin_amdgcn_mfma_f32_16x16x32_bf16((a), (b), (c), 0, 0, 0)

__device__ __forceinline__ int my_tid(int) { return (int)threadIdx.x; }
struct Args { const float* in[17]; float* out; unsigned char* ws; int ph_lo, ph_hi; };
typedef const __attribute__((address_space(4))) Args* KArgP;

__device__ __forceinline__ float wave_sum(float v) {
#pragma unroll
    for (int o = 1; o < 64; o <<= 1) v += __shfl_xor(v, o);
    return v;
}

__device__ __forceinline__ void tr_item(const float* W, int N, int k0, int n0, bf16* dst, int Kp, const float* kgain, LAS float* scr, int lane) {
#pragma unroll 8
    for (int i = 0; i < 32; ++i) { const int kk = 2 * i + (lane >> 5); float v = W[(size_t)(k0 + kk) * N + n0 + (lane & 31)]; if (kgain) v *= kgain[k0 + kk]; scr[kk * 33 + (lane & 31)] = v; }
    asm volatile("s_waitcnt lgkmcnt(0)" ::: "memory");
    const int c = lane & 7;
#pragma unroll
    for (int j = 0; j < 4; ++j) { const int n = (lane >> 3) + 8 * j; const LAS float* s = scr + (8 * c) * 33 + n;
        v4u o; o.x = cvtpk(s[0 * 33], s[1 * 33]); o.y = cvtpk(s[2 * 33], s[3 * 33]); o.z = cvtpk(s[4 * 33], s[5 * 33]); o.w = cvtpk(s[6 * 33], s[7 * 33]);
        *(v4u*)(dst + (size_t)n * Kp + k0 + 8 * c) = o; }
    asm volatile("s_waitcnt lgkmcnt(0)" ::: "memory");
}
__device__ __forceinline__ int win_row(int n0) {
    if (n0 < 1024) return n0;
    if (n0 < 1536) return 2304 + (n0 - 1024);
    if (n0 < 1792) return 1024 + (n0 - 1536);
    if (n0 < 2048) return 1280 + (n0 - 1792);
    if (n0 < 2560) return 2816 + (n0 - 2048);
    if (n0 < 3072) return 1536 + (n0 - 2560);
    return 2048 + (n0 - 3072);
}
__device__ __forceinline__ void rms_row_to_bf16(const float* xrow, const float* gain, bf16* orow, int lane) {
    const f32x4* xr = (const f32x4*)xrow + lane; const f32x4* gr = (const f32x4*)gain + lane;
    f32x4 v[4]; float s = 0.f;
#pragma unroll
    for (int j = 0; j < 4; ++j) { v[j] = xr[64 * j]; s += (v[j].x * v[j].x + v[j].y * v[j].y) + (v[j].z * v[j].z + v[j].w * v[j].w); }
    const float rstd = 1.0f / sqrtf(wave_sum(s) * (1.f / DM) + RMS_EPS);
    v2u* o8 = (v2u*)orow + lane;
#pragma unroll
    for (int j = 0; j < 4; ++j) { const f32x4 g = gr[64 * j]; v2u w; w.x = cvtpk(v[j].x * rstd * g.x, v[j].y * rstd * g.y); w.y = cvtpk(v[j].z * rstd * g.z, v[j].w * rstd * g.w); o8[64 * j] = w; }
}
__device__ __forceinline__ void p0_prologue(const Args& a, LAS unsigned char* lds, int G, const int tid) {
    const int lane = tid & 63, wave = __builtin_amdgcn_readfirstlane(tid >> 6);
    LAS float* scr = (LAS float*)(lds + wave * 16384);
    const int gw = blockIdx.x * NWAVES + wave, NGW = G * NWAVES;
    unsigned char* ws = a.ws;
    bf16* WIN = (bf16*)(ws + WS_WIN); bf16* WOUT = (bf16*)(ws + WS_WOUT); bf16* WGU = (bf16*)(ws + WS_WGU); bf16* WDN = (bf16*)(ws + WS_WDN);
    constexpr int I_IN = 16 * 97, I_OUT = 16 * 32, I_G = 16 * 88, I_D = 44 * 32;
    constexpr int NITEMS = I_IN + I_OUT + 2 * I_G + I_D;
    for (int it = gw; it < NITEMS; it += NGW) {
        int r = it;
        if (r < I_IN) { const int kb = r / 97, nb = r % 97; tr_item(a.in[3], 3104, 64 * kb, 32 * nb, WIN + (size_t)win_row(32 * nb) * DM, DM, nullptr, scr, lane); continue; } r -= I_IN;
        if (r < I_OUT) { const int kb = r / 32, nb = r % 32; tr_item(a.in[11], 1024, 64 * kb, 32 * nb, WOUT + (size_t)(32 * nb) * DM, DM, nullptr, scr, lane); continue; } r -= I_OUT;
        if (r < I_G) { const int kb = r / 88, nb = r % 88; const int n0 = 32 * nb; tr_item(a.in[13], DFF, 64 * kb, n0, WGU + (size_t)((n0 >> 7) * 256 + (n0 & 127)) * DM, DM, a.in[12], scr, lane); continue; } r -= I_G;
        if (r < I_G) { const int kb = r / 88, nb = r % 88; const int n0 = 32 * nb; tr_item(a.in[14], DFF, 64 * kb, n0, WGU + (size_t)((n0 >> 7) * 256 + 128 + (n0 & 127)) * DM, DM, a.in[12], scr, lane); continue; } r -= I_G;
        { const int kb = r / 32, nb = r % 32; tr_item(a.in[15], 1024, 64 * kb, 32 * nb, WDN + (size_t)(32 * nb) * DFF, DFF, nullptr, scr, lane); }
    }
    { const int gt = blockIdx.x * (NWAVES * 64) + tid, NGT = G * NWAVES * 64; const v4u z = {0u, 0u, 0u, 0u};
      v4u* p = (v4u*)(WIN + (size_t)2080 * DM); for (int i = gt; i < 224 * DM * 2 / 16; i += NGT) p[i] = z;
      p = (v4u*)((bf16*)(ws + WS_XN) + (size_t)(META_ROW0 + 16) * DM); for (int i = gt; i < 240 * DM * 2 / 16; i += NGT) p[i] = z;
      p = (v4u*)(ws + WS_SS1); for (int i = gt; i < (2 * MTOK * 4 + 256) / 16; i += NGT) p[i] = z; }
    bf16* XN = (bf16*)(ws + WS_XN);
    for (int m = gw; m < MTOK + 16; m += NGW) { const float* src = m < MTOK ? a.in[0] + (size_t)m * DM : a.in[1] + (size_t)(m - MTOK) * DM; rms_row_to_bf16(src, a.in[2], XN + (size_t)m * DM, lane); }
}

constexpr int NA_K = 0, NA_KSLOT = 64 * 144, NA_V = 9 * NA_KSLOT, NA_VSLOT = 8192, NA_TAB = NA_V + 9 * NA_VSLOT, NA_MB = NA_TAB + 15 * 64 * 4, NA_ITEM = NA_MB + 64, NA_END = NA_ITEM + 64;
static_assert(NA_END <= LDS_BYTES, "NA LDS");
__device__ __forceinline__ int na_s(int i) { return i < 4 ? 0 : (i > 28 ? 24 : i - 4); }
__device__ __forceinline__ void na_item(int item, const Args& a, LAS unsigned char* lds, const int tid) {
    const int lane = tid & 63, w = __builtin_amdgcn_readfirstlane(tid >> 6), fr = lane & 15, fq = lane >> 4;
    const int half = item & 1, h = (item >> 1) & 7, b = item >> 4;
    const bf16* __restrict__ PROJ = (const bf16*)(a.ws + WS_PROJ); const bf16* __restrict__ VT = (const bf16*)(a.ws + WS_VT); bf16* __restrict__ MIX = (bf16*)(a.ws + WS_MIX);
    LAS float* tab = (LAS float*)(lds + NA_TAB); LAS float* mbt = (LAS float*)(lds + NA_MB);
    for (int i = tid; i < 15 * 64; i += NWAVES * 64) { const int x = i & 63, dr = i >> 6; int dc = x - 16; dc = dc < 0 ? 0 : (dc > 30 ? 30 : dc); tab[i] = LOG2E * a.in[4][(h * 15 + dr) * 31 + dc]; }
    if (tid < 16) mbt[tid] = LOG2E * a.in[5][h * 16 + tid];
    const size_t tokbase = (size_t)b * SEQ;
    const int lrow = tid >> 3, lch = tid & 7;
    const bf16* kg = PROJ + (tokbase + lrow) * PROJ_P + PC_NAK + h * 64 + 8 * lch;
    const bf16* vg = VT + (size_t)(h * 64 + lrow) * VT_P + tokbase + 8 * lch;
    const unsigned kdst = NA_K + lrow * 144 + lch * 16, vdst = NA_V + lrow * 128 + ((lch ^ ((lrow >> 1) & 7)) * 16);
    const int qsel = w >> 2, j = w & 3;
    const int c0 = (j == 0) ? 0 : (j == 1) ? 8 : (j == 2) ? 24 : 32;
    const int cq = 16 * j + fr; const int cs = cq < 8 ? 0 : (cq > 56 ? 48 : cq - 8);
    const int kk0 = 8 * (fr >> 2) + (fr & 3);
    const unsigned kbase = NA_K + (c0 + kk0) * 144 + fq * 16, vbase = NA_V + fr * 128 + ((((c0 >> 3) + fq) ^ (fr >> 1)) * 16);
    const int xb = c0 + 8 * fq - cq + 31; const int elo = cs - c0 - 8 * fq;
    const f32x4 z4 = {0.f, 0.f, 0.f, 0.f};
    const bf16* mp = PROJ + (size_t)(META_ROW0 + fr) * PROJ_P + PC_NAK + h * 64 + 8 * fq;
    const bf16x8 mk0 = *(const bf16x8*)mp, mk1 = *(const bf16x8*)(mp + 32);
    v2u mv[4];
    { const bf16* vm = VT + (size_t)(h * 64 + fr) * VT_P + META_ROW0 + 4 * fq;
#pragma unroll
      for (int dt = 0; dt < 4; ++dt) mv[dt] = *(const v2u*)(vm + (size_t)dt * 16 * VT_P); }
    const float mb0 = 0.f;
    const int i0 = 16 * half;
    { const int lo = na_s(i0), hi = na_s(i0 + 1) + 7;
      v4u kr[9], vr[9];
#pragma unroll
      for (int t = 0; t < 9; ++t) { const int row = lo + t; if (row <= hi) { kr[t] = *(const v4u*)(kg + (size_t)row * 64 * PROJ_P); vr[t] = *(const v4u*)(vg + row * 64); } }
#pragma unroll
      for (int t = 0; t < 9; ++t) { const int row = lo + t; if (row <= hi) { const int slot = row % 9; *(LAS v4u*)(lds + kdst + slot * NA_KSLOT) = kr[t]; *(LAS v4u*)(lds + vdst + slot * NA_VSLOT) = vr[t]; } } }
    __syncthreads();
    for (int pair = 0; pair < 8; ++pair) {
        const int ip = i0 + 2 * pair, i = ip + qsel;
        const int hi = na_s(ip + 1) + 7;
        const int nnew = pair < 7 ? na_s(ip + 3) + 7 - hi : 0;
        v4u nk0, nv0, nk1, nv1;
        if (nnew > 0) { nk0 = *(const v4u*)(kg + (size_t)(hi + 1) * 64 * PROJ_P); nv0 = *(const v4u*)(vg + (hi + 1) * 64); }
        if (nnew > 1) { nk1 = *(const v4u*)(kg + (size_t)(hi + 2) * 64 * PROJ_P); nv1 = *(const v4u*)(vg + (hi + 2) * 64); }
        {
            const int s = na_s(i); const int slot0 = s % 9;
            const bf16* qp = PROJ + (tokbase + i * 64 + cq) * PROJ_P + PC_NAQ + h * 64 + 8 * fq;
            const bf16x8 q0 = *(const bf16x8*)qp, q1 = *(const bf16x8*)(qp + 32);
            float sumv;
            f32x4 sc[8][2];
            { bf16x8 kf[8][4];
#pragma unroll
              for (int r = 0; r < 8; ++r) { int slot = slot0 + r; slot = slot >= 9 ? slot - 9 : slot; const LAS unsigned char* p = lds + kbase + slot * NA_KSLOT;
                  kf[r][0] = *(const LAS bf16x8*)p; kf[r][1] = *(const LAS bf16x8*)(p + 64); kf[r][2] = *(const LAS bf16x8*)(p + 576); kf[r][3] = *(const LAS bf16x8*)(p + 640); }
              __builtin_amdgcn_sched_barrier(0);
              asm volatile("s_waitcnt lgkmcnt(0)" ::: "memory");
#pragma unroll
              for (int r = 0; r < 8; ++r) { sc[r][0] = MFMA16(kf[r][0], q0, z4); sc[r][0] = MFMA16(kf[r][1], q1, sc[r][0]);
                  sc[r][1] = MFMA16(kf[r][2], q0, z4); sc[r][1] = MFMA16(kf[r][3], q1, sc[r][1]); } }
            f32x4 sm = MFMA16(mk0, q0, z4); sm = MFMA16(mk1, q1, sm);
            const float QS = 0.125f * LOG2E;
            float mx = -1e30f;
            { float bt[8][8]; float mbv[4];
#pragma unroll
              for (int r = 0; r < 8; ++r) { const LAS float* tr = tab + (s + r - i + 7) * 64 + xb;
#pragma unroll
                  for (int e = 0; e < 8; ++e) bt[r][e] = tr[e]; }
#pragma unroll
              for (int e = 0; e < 4; ++e) mbv[e] = mbt[4 * fq + e];
              __builtin_amdgcn_sched_barrier(0);
              asm volatile("s_waitcnt lgkmcnt(0)" ::: "memory");
#pragma unroll
              for (int r = 0; r < 8; ++r)
#pragma unroll
                  for (int e = 0; e < 8; ++e) { float v = sc[r][e >> 2][e & 3] * QS + bt[r][e]; const bool ok = (e >= elo) & (e < elo + 16); v = ok ? v : -1e30f; sc[r][e >> 2][e & 3] = v; mx = fmaxf(mx, v); }
#pragma unroll
              for (int e = 0; e < 4; ++e) { const float v = sm[e] * QS + mbv[e]; sm[e] = v; mx = fmaxf(mx, v); } }
            f32x4 o[4] = {z4, z4, z4, z4};
            { bf16x8 vf[4][4];
#pragma unroll
              for (int r = 0; r < 4; ++r) { int slot = slot0 + r; slot = slot >= 9 ? slot - 9 : slot; const LAS unsigned char* p = lds + vbase + slot * NA_VSLOT;
#pragma unroll
                  for (int dt = 0; dt < 4; ++dt) vf[r][dt] = *(const LAS bf16x8*)(p + dt * 2048); }
              __builtin_amdgcn_sched_barrier(0);
              mx = fmaxf(mx, __shfl_xor(mx, 16)); mx = fmaxf(mx, __shfl_xor(mx, 32));
              float sum = 0.f;
#pragma unroll
              for (int r = 0; r < 8; ++r)
#pragma unroll
                  for (int e = 0; e < 8; ++e) { const float p = __builtin_amdgcn_exp2f(sc[r][e >> 2][e & 3] - mx); sc[r][e >> 2][e & 3] = p; sum += p; }
#pragma unroll
              for (int e = 0; e < 4; ++e) { const float p = __builtin_amdgcn_exp2f(sm[e] - mx); sm[e] = p; sum += p; }
              sum += __shfl_xor(sum, 16); sum += __shfl_xor(sum, 32);
              sumv = sum;
              bf16x8 pf[8];
#pragma unroll
              for (int r = 0; r < 8; ++r) pf[r] = __builtin_bit_cast(bf16x8, pg8::pack8(sc[r][0], sc[r][1]));
              asm volatile("s_waitcnt lgkmcnt(0)" ::: "memory");
              bf16x8 vg2[4][4];
#pragma unroll
              for (int r = 0; r < 4; ++r) { int slot = slot0 + 4 + r; slot = slot >= 9 ? slot - 9 : slot; const LAS unsigned char* p = lds + vbase + slot * NA_VSLOT;
#pragma unroll
                  for (int dt = 0; dt < 4; ++dt) vg2[r][dt] = *(const LAS bf16x8*)(p + dt * 2048); }
              __builtin_amdgcn_sched_barrier(0);
#pragma unroll
              for (int r = 0; r < 4; ++r)
#pragma unroll
                  for (int dt = 0; dt < 4; ++dt) o[dt] = MFMA16(vf[r][dt], pf[r], o[dt]);
              asm volatile("s_waitcnt lgkmcnt(0)" ::: "memory");
#pragma unroll
              for (int r = 0; r < 4; ++r)
#pragma unroll
                  for (int dt = 0; dt < 4; ++dt) o[dt] = MFMA16(vg2[r][dt], pf[4 + r], o[dt]); }
            { v4u pw; pw.x = cvtpk(sm[0], sm[1]); pw.y = cvtpk(sm[2], sm[3]); pw.z = 0u; pw.w = 0u; const bf16x8 pf = __builtin_bit_cast(bf16x8, pw);
#pragma unroll
              for (int dt = 0; dt < 4; ++dt) { v4u vw; vw.x = mv[dt].x; vw.y = mv[dt].y; vw.z = 0u; vw.w = 0u; o[dt] = MFMA16(__builtin_bit_cast(bf16x8, vw), pf, o[dt]); } }
            const float inv = 1.0f / sumv;
            bf16* op = MIX + (tokbase + i * 64 + cq) * DM + h * 64 + 4 * fq;
#pragma unroll
            for (int dt = 0; dt < 4; ++dt) { v2u ow; ow.x = cvtpk(o[dt][0] * inv, o[dt][1] * inv); ow.y = cvtpk(o[dt][2] * inv, o[dt][3] * inv); *(v2u*)(op + dt * 16) = ow; }
        }
        __syncthreads();
        if (nnew > 0) { const int slot = (hi + 1) % 9; *(LAS v4u*)(lds + kdst + slot * NA_KSLOT) = nk0; *(LAS v4u*)(lds + vdst + slot * NA_VSLOT) = nv0; }
        if (nnew > 1) { const int slot = (hi + 2) % 9; *(LAS v4u*)(lds + kdst + slot * NA_KSLOT) = nk1; *(LAS v4u*)(lds + vdst + slot * NA_VSLOT) = nv1; }
        __syncthreads();
    }
}

constexpr int GP = 72;
constexpr int G_BUF = 3 * 64 * GP * 2 + 256;
constexpr int G_END = 2 * G_BUF;
static_assert(G_END <= LDS_BYTES, "GLA LDS");
constexpr int NCI = 128 * 33;
__device__ __forceinline__ void gla_prep_phase(const Args& a, int G, const int tid) {
    const int lane = tid & 63, w = __builtin_amdgcn_readfirstlane(tid >> 6);
    const bf16* __restrict__ PROJ = (const bf16*)(a.ws + WS_PROJ); const float* __restrict__ GATE = (const float*)(a.ws + WS_GATE);
    unsigned char* GQK = a.ws + WS_GQK; unsigned char* GKD = a.ws + WS_GKD; float* GDEC = (float*)(a.ws + WS_GDEC);
    const f32x4 z4 = {0.f, 0.f, 0.f, 0.f};
    for (int ci = blockIdx.x; ci < NCI; ci += G) {
        const int n = ci % 33, chain = ci / 33, dir = chain & 1, h = (chain >> 1) & 3, b = chain >> 3;
        if (dir && n == 0) continue;
        const int tk = dir ? 63 - lane : lane;
        const int r0 = n ? b * SEQ + 64 * (n - 1) : META_ROW0 - 48; const bool tok_ok = n || lane >= 48;
        v4u q16 = {0u, 0u, 0u, 0u}, k16 = q16; f32x4 lowv[4] = {z4, z4, z4, z4};
        if (tok_ok) { const bf16* p = PROJ + (size_t)(r0 + tk) * PROJ_P + h * 64 + 8 * w; const float* gp = GATE + (size_t)(r0 + tk) * 32 + dir * 16;
            q16 = *(const v4u*)(p + PC_GQ); k16 = *(const v4u*)(p + PC_GK); lowv[0] = *(const f32x4*)gp; lowv[1] = *(const f32x4*)(gp + 4); lowv[2] = *(const f32x4*)(gp + 8); lowv[3] = *(const f32x4*)(gp + 12); }
        const float* W = (dir ? a.in[8] : a.in[6]) + h * 64 + 8 * w; const float* B = (dir ? a.in[9] : a.in[7]) + h * 64 + 8 * w;
        float g[8], tot[8];
        { const f32x4 b0 = *(const f32x4*)B, b1 = *(const f32x4*)(B + 4);
#pragma unroll
          for (int j = 0; j < 4; ++j) { g[j] = b0[j]; g[4 + j] = b1[j]; }
#pragma unroll
          for (int r = 0; r < 16; ++r) { const f32x4 w0 = *(const f32x4*)(W + r * 256), w1 = *(const f32x4*)(W + r * 256 + 4); const float l = lowv[r >> 2][r & 3];
#pragma unroll
              for (int j = 0; j < 4; ++j) { g[j] += l * w0[j]; g[4 + j] += l * w1[j]; } }
#pragma unroll
          for (int j = 0; j < 8; ++j) { const float z = g[j] * LOG2E; float v = (fminf(z, 0.f) - __builtin_amdgcn_logf(1.0f + __builtin_amdgcn_exp2f(-fabsf(z)))) * (1.0f / 16.0f); g[j] = tok_ok ? v : 0.f; } }
#define DPP_SHR(v, n) __builtin_bit_cast(float, __builtin_amdgcn_update_dpp(0, __builtin_bit_cast(int, (v)), 0x110 + (n), 0xf, 0xf, true))
#pragma unroll
        for (int j = 0; j < 8; ++j) { float v = g[j];
            v += DPP_SHR(v, 1); v += DPP_SHR(v, 2); v += DPP_SHR(v, 4); v += DPP_SHR(v, 8);
            const int vi = __builtin_bit_cast(int, v);
            const float r0_ = __builtin_bit_cast(float, __builtin_amdgcn_readlane(vi, 15)), r1_ = __builtin_bit_cast(float, __builtin_amdgcn_readlane(vi, 31)), r2_ = __builtin_bit_cast(float, __builtin_amdgcn_readlane(vi, 47)), r3_ = __builtin_bit_cast(float, __builtin_amdgcn_readlane(vi, 63));
            v += (lane >= 16 ? r0_ : 0.f) + (lane >= 32 ? r1_ : 0.f) + (lane >= 48 ? r2_ : 0.f);
            g[j] = v; tot[j] = (r0_ + r1_) + (r2_ + r3_); }
#undef DPP_SHR
        bf16* kdt = (bf16*)(GKD + (size_t)ci * 8192);
        unsigned qw[4], kw[4];
#pragma unroll
        for (int j2 = 0; j2 < 4; ++j2) { float qe[2], ke[2];
#pragma unroll
            for (int x = 0; x < 2; ++x) { const int j = 2 * j2 + x;
                const float eb = __builtin_amdgcn_exp2f(g[j]), enb = __builtin_amdgcn_rcpf(eb), dec = __builtin_amdgcn_exp2f(tot[j]);
                const unsigned qraw = q16[j2], kraw = k16[j2];
                const float qf = x ? __uint_as_float(qraw & 0xffff0000u) : __uint_as_float(qraw << 16), kf = x ? __uint_as_float(kraw & 0xffff0000u) : __uint_as_float(kraw << 16);
                qe[x] = qf * 0.125f * eb; ke[x] = kf * enb;
                kdt[(8 * w + j) * 64 + tk] = (bf16)(cvtpk(ke[x] * dec, 0.f) & 0xffffu); }
            qw[j2] = cvtpk(qe[0], qe[1]); kw[j2] = cvtpk(ke[0], ke[1]); }
        v4u* qk = (v4u*)(GQK + (size_t)ci * 16384) + w * 64 + tk;
        qk[0] = (v4u){qw[0], qw[1], qw[2], qw[3]}; qk[512] = (v4u){kw[0], kw[1], kw[2], kw[3]};
        float dsel = tot[0];
#pragma unroll
        for (int j = 1; j < 8; ++j) dsel = lane == j ? tot[j] : dsel;
        if (lane < 8) GDEC[(size_t)ci * 64 + 8 * w + lane] = __builtin_amdgcn_exp2f(dsel);
    }
}
template <int dir> __device__ __forceinline__ void gla_item(int item, const Args& a, LAS unsigned char* lds, const int tid) {
    const int lane = tid & 63, w = __builtin_amdgcn_readfirstlane(tid >> 6), fr = lane & 15, fq = lane >> 4;
    const int h = (item >> 1) & 3, b = item >> 3;
    const bf16* __restrict__ VT = (const bf16*)(a.ws + WS_VT);
    const unsigned char* GQK = a.ws + WS_GQK + (size_t)item * 33 * 16384; const unsigned char* GKD = a.ws + WS_GKD + (size_t)item * 33 * 8192; const float* GDEC = (const float*)(a.ws + WS_GDEC) + (size_t)item * 33 * 64;
    bf16* OG = (bf16*)(a.ws + WS_OG) + (size_t)dir * MTOK * 512;
    const f32x4 z4 = {0.f, 0.f, 0.f, 0.f};
    f32x4 st[4] = {z4, z4, z4, z4};
    const int nsteps = dir ? 32 : 33;
    const int kk0 = 8 * (fr >> 2) + (fr & 3);
    const unsigned d_qe = (unsigned)((tid & 63) * GP * 2 + (tid >> 6) * 16), d_kd = (unsigned)(2 * 64 * GP * 2 + (tid >> 3) * GP * 2 + (tid & 7) * 16);
    v4u cq, ck, cd; f32x4 cdec = z4; bf16x8 vf0, vf1;
#define GLA_LOAD(n_, Q, K, D, DC, V0, V1) do { const int n__ = (n_); const int r0_ = n__ ? b * SEQ + 64 * (n__ - 1) : META_ROW0 - 48; \
        const v4u* s_ = (const v4u*)(GQK + (size_t)n__ * 16384) + tid; Q = s_[0]; K = s_[512]; D = ((const v4u*)(GKD + (size_t)n__ * 8192))[tid]; \
        if (tid < 16) DC = ((const f32x4*)(GDEC + n__ * 64))[tid]; \
        const bf16* v_ = VT + (size_t)(512 + h * 128 + 16 * w + fr) * VT_P + r0_ + 8 * fq; V0 = *(const bf16x8*)v_; V1 = *(const bf16x8*)(v_ + 32); } while (0)
    GLA_LOAD(dir ? 32 : 0, cq, ck, cd, cdec, vf0, vf1);
    for (int step = 0; step < nsteps; ++step) {
        const int n = dir ? 32 - step : step;
        const int row0 = n ? b * SEQ + 64 * (n - 1) : META_ROW0 - 48;
        LAS unsigned char* buf = lds + (step & 1) * G_BUF;
        LAS bf16* QE = (LAS bf16*)buf; LAS bf16* KE = QE + 64 * GP; LAS bf16* KDT = KE + 64 * GP; LAS float* DEC = (LAS float*)(buf + 3 * 64 * GP * 2);
        *(LAS v4u*)(buf + d_qe) = cq; *(LAS v4u*)(buf + 64 * GP * 2 + d_qe) = ck; *(LAS v4u*)(buf + d_kd) = cd;
        if (tid < 16) *(LAS f32x4*)(DEC + 4 * tid) = cdec;
        const bf16x8 cvf0 = vf0, cvf1 = vf1;
        if (step + 1 < nsteps) GLA_LOAD(dir ? 31 - step : step + 1, cq, ck, cd, cdec, vf0, vf1);
        __syncthreads();
        bf16x8 keF[2][2][2], kdF[4][2]; f32x4 dcv[4];
#pragma unroll
        for (int kg = 0; kg < 2; ++kg)
#pragma unroll
            for (int t = 0; t < 2; ++t)
#pragma unroll
                for (int dks = 0; dks < 2; ++dks) keF[kg][t][dks] = *(const LAS bf16x8*)(KE + (32 * kg + kk0 + 4 * t) * GP + 32 * dks + 8 * fq);
        const bf16x8 sf0 = __builtin_bit_cast(bf16x8, pg8::pack8(st[0], st[1])), sf1 = __builtin_bit_cast(bf16x8, pg8::pack8(st[2], st[3]));
#pragma unroll
        for (int qh = 0; qh < 2; ++qh) {
            bf16x8 yq[2][2]; v2u ypr[2][4];
#pragma unroll
            for (int q2 = 0; q2 < 2; ++q2) { const LAS bf16* qrow = QE + (16 * (2 * qh + q2) + fr) * GP;
#pragma unroll
                for (int dks = 0; dks < 2; ++dks) yq[q2][dks] = *(const LAS bf16x8*)(qrow + 32 * dks + 8 * fq);
#pragma unroll
                for (int c = 0; c < 4; ++c) ypr[q2][c] = *(const LAS v2u*)(qrow + 16 * c + 4 * fq); }
            if (qh == 1) {
#pragma unroll
                for (int dkt = 0; dkt < 4; ++dkt) { kdF[dkt][0] = *(const LAS bf16x8*)(KDT + (16 * dkt + fr) * GP + 8 * fq); kdF[dkt][1] = *(const LAS bf16x8*)(KDT + (16 * dkt + fr) * GP + 32 + 8 * fq); dcv[dkt] = *(const LAS f32x4*)(DEC + 16 * dkt + 4 * fq); } }
            __builtin_amdgcn_sched_barrier(0);
            asm volatile("s_waitcnt lgkmcnt(0)" ::: "memory");
            if (n) {
#pragma unroll
                for (int q2 = 0; q2 < 2; ++q2) { const int qt = 2 * qh + q2; f32x4 o = z4;
#pragma unroll
                    for (int kg = 0; kg < 2; ++kg) {
                        const bool need = dir ? (kg == 1 || qt < 2) : (kg == 0 || qt >= 2);
                        if (need) {
                            f32x4 s0 = MFMA16(keF[kg][0][0], yq[q2][0], z4); s0 = MFMA16(keF[kg][0][1], yq[q2][1], s0);
                            f32x4 s1 = MFMA16(keF[kg][1][0], yq[q2][0], z4); s1 = MFMA16(keF[kg][1][1], yq[q2][1], s1);
                            const int qi = 16 * qt + fr, kb = 32 * kg + 8 * fq;
#pragma unroll
                            for (int e = 0; e < 4; ++e) { const bool k0 = dir ? (kb + e >= qi) : (kb + e <= qi); const bool k1 = dir ? (kb + 4 + e >= qi) : (kb + 4 + e <= qi); s0[e] = k0 ? s0[e] : 0.f; s1[e] = k1 ? s1[e] : 0.f; }
                            const bf16x8 pf = __builtin_bit_cast(bf16x8, pg8::pack8(s0, s1));
                            o = MFMA16(kg ? cvf1 : cvf0, pf, o);
                        }
                    }
                    const v4u y0 = {ypr[q2][0].x, ypr[q2][0].y, ypr[q2][1].x, ypr[q2][1].y}, y1 = {ypr[q2][2].x, ypr[q2][2].y, ypr[q2][3].x, ypr[q2][3].y};
                    o = MFMA16(sf0, __builtin_bit_cast(bf16x8, y0), o); o = MFMA16(sf1, __builtin_bit_cast(bf16x8, y1), o);
                    v2u ow; ow.x = cvtpk(o[0], o[1]); ow.y = cvtpk(o[2], o[3]);
                    *(v2u*)(OG + (size_t)(row0 + 16 * qt + fr) * 512 + h * 128 + 16 * w + 4 * fq) = ow;
                }
            }
        }
#pragma unroll
        for (int dkt = 0; dkt < 4; ++dkt) { st[dkt] = st[dkt] * dcv[dkt];
            st[dkt] = MFMA16(kdF[dkt][0], cvf0, st[dkt]); st[dkt] = MFMA16(kdF[dkt][1], cvf1, st[dkt]); }
    }
#undef GLA_LOAD
    __syncthreads();
}

__device__ __forceinline__ void gla_combine(const Args& a, int G, const int tid) {
    const int lane = tid & 63, wave = tid >> 6, sub = lane >> 4, l = lane & 15;
    const bf16* OG0 = (const bf16*)(a.ws + WS_OG); const bf16* OG1 = OG0 + (size_t)MTOK * 512; const bf16* PROJ = (const bf16*)(a.ws + WS_PROJ); bf16* MIX = (bf16*)(a.ws + WS_MIX);
    const float* gain = a.in[10];
    const int gw = blockIdx.x * NWAVES + wave, NGW = G * NWAVES;
    float gn[8];
#pragma unroll
    for (int e = 0; e < 8; ++e) gn[e] = gain[8 * l + e];
    for (int pr = gw * 4 + sub; pr < MTOK * 4; pr += NGW * 4) {
        const int tok = pr >> 2, h = pr & 3;
        const v4u f = *(const v4u*)(OG0 + (size_t)tok * 512 + h * 128 + 8 * l), bw = *(const v4u*)(OG1 + (size_t)tok * 512 + h * 128 + 8 * l), rr = *(const v4u*)(PROJ + (size_t)tok * PROJ_P + PC_GR + h * 128 + 8 * l);
        float o[8], rv[8]; float ss = 0.f;
#pragma unroll
        for (int e = 0; e < 4; ++e) { const unsigned fw = f[e], bwv = bw[e], rw = rr[e];
            o[2 * e] = __uint_as_float(fw << 16) + __uint_as_float(bwv << 16); o[2 * e + 1] = __uint_as_float(fw & 0xffff0000u) + __uint_as_float(bwv & 0xffff0000u);
            rv[2 * e] = __uint_as_float(rw << 16); rv[2 * e + 1] = __uint_as_float(rw & 0xffff0000u); }
#pragma unroll
        for (int e = 0; e < 8; ++e) ss += o[e] * o[e];
        ss += __shfl_xor(ss, 1); ss += __shfl_xor(ss, 2); ss += __shfl_xor(ss, 4); ss += __shfl_xor(ss, 8);
        const float rstd = 1.0f / sqrtf(ss * (1.0f / 128.0f) + RMS_EPS);
        float y[8];
#pragma unroll
        for (int e = 0; e < 8; ++e) { const float r = rv[e]; y[e] = o[e] * rstd * gn[e] * (r / (1.0f + __expf(-r))); }
        v4u ow; ow.x = cvtpk(y[0], y[1]); ow.y = cvtpk(y[2], y[3]); ow.z = cvtpk(y[4], y[5]); ow.w = cvtpk(y[6], y[7]);
        *(v4u*)(MIX + (size_t)tok * DM + 512 + h * 128 + 8 * l) = ow;
    }
}

__device__ __forceinline__ void final_norm(const Args& a, int G, const int tid) {
    const int lane = tid & 63, wave = tid >> 6;
    const float* SS2 = (const float*)(a.ws + WS_SS2); const f32x4* gr = (const f32x4*)a.in[16] + lane;
    f32x4 g[4];
#pragma unroll
    for (int j = 0; j < 4; ++j) g[j] = gr[64 * j];
    const int gw = blockIdx.x * NWAVES + wave, NGW = G * NWAVES;
    for (int m = gw; m < MTOK; m += NGW) { const float rstd = 1.0f / sqrtf(SS2[m] * (1.0f / DM) + RMS_EPS); f32x4* p = (f32x4*)(a.out + (size_t)m * DM) + lane;
#pragma unroll
        for (int j = 0; j < 4; ++j) { f32x4 v = p[64 * j]; v = v * rstd * g[j]; p[64 * j] = v; } }
}

constexpr int NPHASE = 9;
__global__ void __launch_bounds__(NWAVES * 64, 2) mega_fwd(Args args) {
    extern __shared__ __attribute__((aligned(16))) unsigned char lds_raw[];
    LAS unsigned char* lds = (LAS unsigned char*)lds_raw;
    cg::grid_group grid = cg::this_grid();
    const int G = gridDim.x;
    const int wave_s = 0; (void)wave_s;
    const int lo = args.ph_lo, hi = args.ph_hi;
#define IN(k) (lo <= (k) && (k) < hi)
#if defined(__HIP_DEVICE_COMPILE__)
#define PHASE_ARGS() KArgP kap_ = (KArgP)__builtin_amdgcn_kernarg_segment_ptr(); asm volatile("" : "+s"(kap_)); const Args A = *kap_; unsigned char* ws = A.ws; (void)ws
#else
#define PHASE_ARGS() const Args A = args; unsigned char* ws = A.ws; (void)ws
#endif
#define SEAM(k) do { if (IN(k) && IN((k) + 1)) grid.sync(); } while (0)
    if (IN(0)) { PHASE_ARGS(); p0_prologue(A, lds, G, my_tid(wave_s)); } SEAM(0);
    if (IN(1)) {
        PHASE_ARGS();
        pg8::Gemm g{(const pg8::bf16_t*)(ws + WS_XN), (const pg8::bf16_t*)(ws + WS_XN), MROWS + WIN_ROWS, MROWS + WIN_ROWS, DM};
        pg8::SchedP1 S; S.init(G, (int)blockIdx.x);
        pg8::EpiProj E{(pg8::bf16_t*)(ws + WS_PROJ), (float*)(ws + WS_GATE), (pg8::bf16_t*)(ws + WS_VT)};
        pg8::gemm_phase<pg8::EpiProj, pg8::SchedP1, true, true>(lds, g, S, E, my_tid(wave_s));
    } SEAM(1);
    if (IN(2)) { PHASE_ARGS(); gla_prep_phase(A, G, my_tid(wave_s)); } SEAM(2);
    if (IN(3)) {
        PHASE_ARGS(); const int tid2 = my_tid(wave_s);
        if (blockIdx.x < 128) { if (blockIdx.x & 1) gla_item<1>((int)blockIdx.x, A, lds, tid2); else gla_item<0>((int)blockIdx.x, A, lds, tid2); }
        unsigned* ctr = (unsigned*)(ws + WS_CTR);
        for (;;) {
            if (tid2 == 0) *(LAS unsigned*)(lds + NA_ITEM) = atomicAdd(ctr, 1u);
            __syncthreads();
            const unsigned it = (unsigned)__builtin_amdgcn_readfirstlane((int)*(LAS unsigned*)(lds + NA_ITEM));
            __syncthreads();
            if (it >= 256u) break;
            na_item((int)it, A, lds, tid2);
        }
    } SEAM(3);
    if (IN(4)) { PHASE_ARGS(); gla_combine(A, G, my_tid(wave_s)); } SEAM(4);
    if (IN(5)) {
        PHASE_ARGS();
        pg8::Gemm g{(const pg8::bf16_t*)(ws + WS_MIX), (const pg8::bf16_t*)(ws + WS_WOUT), MTOK, DM, DM};
        pg8::StaticOrder S; S.init(MTOK, DM, G, (int)blockIdx.x);
        pg8::EpiRes1 E{A.in[0], A.out, (pg8::bf16_t*)(ws + WS_XN), (float*)(ws + WS_SS1)};
        pg8::gemm_phase<pg8::EpiRes1, pg8::StaticOrder, true, true>(lds, g, S, E, my_tid(wave_s));
    } SEAM(5);
    if (IN(6)) {
        PHASE_ARGS();
        pg8::Gemm g{(const pg8::bf16_t*)(ws + WS_XN), (const pg8::bf16_t*)(ws + WS_WGU), MTOK, 2 * DFF, DM};
        pg8::StaticOrder S; S.init(MTOK, 2 * DFF, G, (int)blockIdx.x);
        pg8::EpiSwiglu E{(pg8::bf16_t*)(ws + WS_F), (const float*)(ws + WS_SS1)};
        pg8::gemm_phase<pg8::EpiSwiglu, pg8::StaticOrder, true, true>(lds, g, S, E, my_tid(wave_s));
    } SEAM(6);
    if (IN(7)) {
        PHASE_ARGS();
        pg8::Gemm g{(const pg8::bf16_t*)(ws + WS_F), (const pg8::bf16_t*)(ws + WS_WDN), MTOK, DM, DFF};
        pg8::StaticOrder S; S.init(MTOK, DM, G, (int)blockIdx.x);
        pg8::EpiRes2 E{A.out, (float*)(ws + WS_SS2)};
        pg8::gemm_phase<pg8::EpiRes2, pg8::StaticOrder, true, true>(lds, g, S, E, my_tid(wave_s));
    } SEAM(7);
    if (IN(8)) { PHASE_ARGS(); final_norm(A, G, my_tid(wave_s)); }
#undef IN
#undef SEAM
#undef PHASE_ARGS
}

extern "C" void kernel_launch(void* const* d_in, const int* in_sizes, int n_in, void* d_out, int out_size, void* d_ws, size_t ws_size, hipStream_t stream) {
    static int grid = 0;
    if (grid == 0) {
        if (n_in != 17 || in_sizes[0] != MTOK * DM || out_size != MTOK * DM || ws_size < WS_END) { fprintf(stderr, "kernel_launch: unexpected shapes (n_in %d, in0 %d, out %d, ws %zu need %zu)\n", n_in, n_in > 0 ? in_sizes[0] : -1, out_size, ws_size, (size_t)WS_END); grid = -1; return; }
        int dev = 0, cus = 0, per_cu = 0;
        hipGetDevice(&dev); hipDeviceGetAttribute(&cus, hipDeviceAttributeMultiprocessorCount, dev);
        if (hipFuncSetAttribute((const void*)mega_fwd, hipFuncAttributeMaxDynamicSharedMemorySize, LDS_BYTES) != hipSuccess) { fprintf(stderr, "kernel_launch: hipFuncSetAttribute failed\n"); grid = -1; return; }
        if (hipOccupancyMaxActiveBlocksPerMultiprocessor(&per_cu, (const void*)mega_fwd, NWAVES * 64, LDS_BYTES) != hipSuccess || per_cu < 1) { fprintf(stderr, "kernel_launch: occupancy query says %d\n", per_cu); per_cu = 1; }
        (void)hipGetLastError();
        grid = cus;
        if (grid > 256) grid = 256;
    }
    if (grid < 0) return;
    Args a{};
    for (int i = 0; i < 17; ++i) a.in[i] = (const float*)d_in[i];
    a.out = (float*)d_out; a.ws = (unsigned char*)d_ws;
#if MK_N_LAUNCHES == 1
    a.ph_lo = 0; a.ph_hi = NPHASE;
    void* kargs[] = {&a};
    hipError_t e = hipLaunchCooperativeKernel((const void*)mega_fwd, dim3(grid), dim3(NWAVES * 64), kargs, LDS_BYTES, stream);
    if (e != hipSuccess) fprintf(stderr, "cooperative launch failed: %s (grid %d)\n", hipGetErrorString(e), grid);
#else
    for (int p = 0; p < NPHASE; ++p) { a.ph_lo = p; a.ph_hi = p + 1; hipLaunchKernelGGL(mega_fwd, dim3(grid), dim3(NWAVES * 64), LDS_BYTES, stream, a); }
#endif
}
```

```cpp
#include <hip/hip_runtime.h>
#include <hip/hip_cooperative_groups.h>
#include <cstdio>
#include <cstdint>
namespace cg = cooperative_groups;

#ifndef MK_N_LAUNCHES
#define MK_N_LAUNCHES 1
#endif

namespace pg8 {
#define PG8_LAS __attribute__((address_space(3)))
typedef unsigned short bf16_t;
typedef short bf16x8 __attribute__((ext_vector_type(8)));
typedef float f32x4 __attribute__((ext_vector_type(4)));
typedef unsigned u32x4 __attribute__((ext_vector_type(4)));
constexpr int BM = 256, BK = 64, HALF = 128, HTB = HALF * BK * 2  , STAGE_BYTES = 8 * HTB, NXCD = 8, WGM = 8;

__host__ __device__ __forceinline__ int lds_byte(int r, int c) { const int st = (r >> 4) * 2 + (c >> 5), rr = r & 15, cc = c & 31, ob = rr * 64 + cc * 2; return st * 1024 + (ob ^ (((ob >> 9) & 1) << 5)); }
__host__ __device__ __forceinline__ void stage_rc(int b, int& R, int& C) { const int st = b / 1024, sb = b % 1024, swz = sb ^ (((sb >> 9) & 1) << 5); R = (st >> 1) * 16 + swz / 64; C = (st & 1) * 32 + (swz % 64) / 2; }
__host__ __device__ __forceinline__ int perm32(int rho) { const int n = rho >> 4, i = rho & 15; return 8 * (i >> 2) + 4 * n + (i & 3); }

struct Unit { int pm, pn; };
struct Gemm { const bf16_t* A; const bf16_t* Bt; int M, N, K; };

struct StaticOrder {
    int nM, nN, nwg, G, c;
    __host__ __device__ void init(int M, int N, int G_, int c_) { nM = M / BM; nN = N / BM; nwg = nM * nN; G = G_; c = c_; }
    __host__ __device__ bool next(int i, Unit& u) const {
        const long L = (long)i * G + c; if (L >= nwg) return false;
        int wgid = (int)L; { const int q = nwg / NXCD, r = nwg % NXCD, xcd = wgid % NXCD, off = wgid / NXCD; wgid = (xcd < r ? xcd * (q + 1) : r * (q + 1) + (xcd - r) * q) + off; }
        const int nig = WGM * nN, gid = wgid / nig, fm = gid * WGM, gsz = (nM - fm) < WGM ? (nM - fm) : WGM;
        u.pm = fm + ((wgid % nig) % gsz); u.pn = (wgid % nig) / gsz; return true;
    }
    __device__ __forceinline__ void a_ready(const Unit&) const {}
    __device__ __forceinline__ void done(const Unit&) const {}
};

typedef float f32x2_t __attribute__((ext_vector_type(2))); typedef __bf16 bf16x2_t __attribute__((ext_vector_type(2)));
__device__ __forceinline__ unsigned cvtpk(float lo, float hi) { f32x2_t v = {lo, hi}; bf16x2_t b = __builtin_convertvector(v, bf16x2_t); return __builtin_bit_cast(unsigned, b); }
__device__ __forceinline__ u32x4 pack8(const f32x4 a, const f32x4 b) { u32x4 w; w.x = cvtpk(a[0], a[1]); w.y = cvtpk(a[2], a[3]); w.z = cvtpk(b[0], b[1]); w.w = cvtpk(b[2], b[3]); return w; }

constexpr int NTT = 129;
constexpr int PROJ_P = 2048;
constexpr int VT_P = 33024;

struct EpiProj {
    static constexpr bool PERM = true, AFTER_DRAIN = false;
    bf16_t* PROJ; float* GATE; bf16_t* VT;
    __device__ __forceinline__ void operator()(const f32x4 (&acc)[2][2][4][2], const Unit& u, int wr, int wc, int fr, int fq) const {
        if (u.pm < NTT) {
            const int wt = u.pn - NTT; const int row0 = u.pm * BM + wr * 64 + fr;
            if (wt < 8) {
                const int col0 = wt * BM + wc * 32 + 8 * fq;
#pragma unroll
                for (int ai = 0; ai < 2; ++ai)
#pragma unroll
                    for (int m = 0; m < 4; ++m) { bf16_t* rowp = PROJ + (size_t)(row0 + ai * HALF + m * 16) * PROJ_P + col0;
#pragma unroll
                        for (int bj = 0; bj < 2; ++bj) *(u32x4*)(rowp + bj * HALF) = pack8(acc[ai][bj][m][0], acc[ai][bj][m][1]); }
            } else if (wc == 0) {
#pragma unroll
                for (int ai = 0; ai < 2; ++ai)
#pragma unroll
                    for (int m = 0; m < 4; ++m) { float* rowp = GATE + (size_t)(row0 + ai * HALF + m * 16) * 32 + 8 * fq;
                        *(f32x4*)rowp = acc[ai][0][m][0]; *(f32x4*)(rowp + 4) = acc[ai][0][m][1]; }
            }
        } else {
            const int wt = u.pm - NTT - 9; const int row0 = wt * BM + wr * 64 + fr; const int col0 = u.pn * BM + wc * 32 + 8 * fq;
#pragma unroll
            for (int ai = 0; ai < 2; ++ai)
#pragma unroll
                for (int m = 0; m < 4; ++m) { bf16_t* rowp = VT + (size_t)(row0 + ai * HALF + m * 16) * VT_P + col0;
#pragma unroll
                    for (int bj = 0; bj < 2; ++bj) *(u32x4*)(rowp + bj * HALF) = pack8(acc[ai][bj][m][0], acc[ai][bj][m][1]); }
        }
    }
};
struct EpiRes1 {
    static constexpr bool PERM = true, AFTER_DRAIN = false;
    const float* X; float* H1; bf16_t* HB; float* SS;
    __device__ __forceinline__ void operator()(const f32x4 (&acc)[2][2][4][2], const Unit& u, int wr, int wc, int fr, int fq) const {
        const int row0 = u.pm * BM + wr * 64 + fr, col0 = u.pn * BM + wc * 32 + 8 * fq;
#pragma unroll
        for (int ai = 0; ai < 2; ++ai)
#pragma unroll
            for (int m = 0; m < 4; ++m) { const int r = row0 + ai * HALF + m * 16; const size_t off = (size_t)r * 1024 + col0; float ss = 0.f;
#pragma unroll
                for (int bj = 0; bj < 2; ++bj) { const f32x4 x0 = *(const f32x4*)(X + off + bj * HALF), x1 = *(const f32x4*)(X + off + bj * HALF + 4);
                    const f32x4 v0 = acc[ai][bj][m][0] + x0, v1 = acc[ai][bj][m][1] + x1;
                    *(f32x4*)(H1 + off + bj * HALF) = v0; *(f32x4*)(H1 + off + bj * HALF + 4) = v1; *(u32x4*)(HB + off + bj * HALF) = pack8(v0, v1);
                    ss += (v0[0] * v0[0] + v0[1] * v0[1]) + (v0[2] * v0[2] + v0[3] * v0[3]) + (v1[0] * v1[0] + v1[1] * v1[1]) + (v1[2] * v1[2] + v1[3] * v1[3]); }
                ss += __shfl_xor(ss, 16); ss += __shfl_xor(ss, 32);
                if (fq == 0) atomicAdd(SS + r, ss); }
    }
};
struct EpiSwiglu {
    static constexpr bool PERM = true, AFTER_DRAIN = false;
    bf16_t* F; const float* SS;
    __device__ __forceinline__ void operator()(const f32x4 (&acc)[2][2][4][2], const Unit& u, int wr, int wc, int fr, int fq) const {
        const int row0 = u.pm * BM + wr * 64 + fr, col0 = u.pn * HALF + wc * 32 + 8 * fq;
#pragma unroll
        for (int ai = 0; ai < 2; ++ai)
#pragma unroll
            for (int m = 0; m < 4; ++m) { const int r = row0 + ai * HALF + m * 16; const float rstd = 1.0f / sqrtf(SS[r] * (1.0f / 1024.0f) + 1e-6f);
                f32x4 o[2];
#pragma unroll
                for (int n = 0; n < 2; ++n) { const f32x4 g = acc[ai][0][m][n] * rstd, up = acc[ai][1][m][n] * rstd;
#pragma unroll
                    for (int e = 0; e < 4; ++e) o[n][e] = g[e] * __builtin_amdgcn_rcpf(1.0f + __builtin_amdgcn_exp2f(-1.4426950408889634f * g[e])) * up[e]; }
                *(u32x4*)(F + (size_t)r * 2816 + col0) = pack8(o[0], o[1]); }
    }
};
struct EpiRes2 {
    static constexpr bool PERM = true, AFTER_DRAIN = false;
    float* H; float* SS;
    __device__ __forceinline__ void operator()(const f32x4 (&acc)[2][2][4][2], const Unit& u, int wr, int wc, int fr, int fq) const {
        const int row0 = u.pm * BM + wr * 64 + fr, col0 = u.pn * BM + wc * 32 + 8 * fq;
#pragma unroll
        for (int ai = 0; ai < 2; ++ai)
#pragma unroll
            for (int m = 0; m < 4; ++m) { const int r = row0 + ai * HALF + m * 16; const size_t off = (size_t)r * 1024 + col0; float ss = 0.f;
#pragma unroll
                for (int bj = 0; bj < 2; ++bj) { const f32x4 x0 = *(const f32x4*)(H + off + bj * HALF), x1 = *(const f32x4*)(H + off + bj * HALF + 4);
                    const f32x4 v0 = acc[ai][bj][m][0] + x0, v1 = acc[ai][bj][m][1] + x1;
                    *(f32x4*)(H + off + bj * HALF) = v0; *(f32x4*)(H + off + bj * HALF + 4) = v1;
                    ss += (v0[0] * v0[0] + v0[1] * v0[1]) + (v0[2] * v0[2] + v0[3] * v0[3]) + (v1[0] * v1[0] + v1[1] * v1[1]) + (v1[2] * v1[2] + v1[3] * v1[3]); }
                ss += __shfl_xor(ss, 16); ss += __shfl_xor(ss, 32);
                if (fq == 0) atomicAdd(SS + r, ss); }
    }
};
struct TileOrder {
    int nM, nN, nwg;
    __device__ void init(int nM_, int nN_) { nM = nM_; nN = nN_; nwg = nM * nN; }
    __device__ void map(int L, int& pm, int& pn) const {
        int wgid = L; { const int q = nwg / NXCD, r = nwg % NXCD, xcd = wgid % NXCD, off = wgid / NXCD; wgid = (xcd < r ? xcd * (q + 1) : r * (q + 1) + (xcd - r) * q) + off; }
        const int nig = WGM * nN, gid = wgid / nig, fm = gid * WGM, gsz = (nM - fm) < WGM ? (nM - fm) : WGM;
        pm = fm + ((wgid % nig) % gsz); pn = (wgid % nig) / gsz;
    }
};
struct SchedP1 {
    TileOrder a, b; int G, c;
    __device__ void init(int G_, int c_) { a.init(NTT, 9); b.init(4, NTT); G = G_; c = c_; }
    __device__ bool next(int i, Unit& u) const {
        const long L = (long)i * G + c; if (L >= a.nwg + b.nwg) return false;
        int pm, pn;
        if (L < a.nwg) { a.map((int)L, pm, pn); u.pm = pm; u.pn = NTT + pn; }
        else { b.map((int)L - a.nwg, pm, pn); u.pm = NTT + 9 + pm; u.pn = pn; }
        return true;
    }
    __device__ __forceinline__ void a_ready(const Unit&) const {}
    __device__ __forceinline__ void done(const Unit&) const {}
};
template <class Epi, class Sched, bool ALIGN_EPI = false, bool SP2 = false>
__device__ __forceinline__ void gemm_phase(PG8_LAS unsigned char* lds, const Gemm g, const Sched& S, const Epi& E, const int tid) {
    const int wid = __builtin_amdgcn_readfirstlane(tid >> 6), lane = tid & 63, wr = wid >> 2, wc = wid & 3, fr = lane & 15, fq = lane >> 4;
    const int K = g.K, nt = K / BK;
    unsigned voffA[2], voffB[2];
#pragma unroll
    for (int i = 0; i < 2; ++i) { int R, C; stage_rc(tid * 16 + i * 8192, R, C); const int Rb = Epi::PERM ? ((R & ~31) + perm32(R & 31)) : R;
        voffA[i] = (unsigned)(R * K + C) * 2u; voffB[i] = (unsigned)(Rb * K + C) * 2u; }
    const size_t kstep = (size_t)(BK * 2);
    const size_t hstep = (size_t)HALF * K * 2;
    const size_t tstep = 2 * hstep;
    const unsigned ldsw = (unsigned)wid * 1024u;
    const int aoff = lds_byte(wr * 64 + fr, fq * 8), boff = lds_byte(wc * 32 + fr, fq * 8);
#define PG8_SA(b, h) (((b) * 2 + (h)) * HTB)
#define PG8_SB(b, h) ((4 + (b) * 2 + (h)) * HTB)
#define PG8_STAGE(bufoff, gbase, voff) do { _Pragma("unroll") for (int _i = 0; _i < 2; ++_i) \
        __builtin_amdgcn_global_load_lds((const unsigned*)((const char*)(gbase) + (voff)[_i]), (PG8_LAS unsigned*)(lds + (bufoff) + ldsw + _i * 8192), 16, 0, 0); } while (0)
#define PG8_LDA(dst, b, h) do { _Pragma("unroll") for (int m = 0; m < 4; ++m) _Pragma("unroll") for (int k = 0; k < 2; ++k) dst[m][k] = *(const PG8_LAS bf16x8*)(lds + PG8_SA(b, h) + aoff + m * 2048 + k * 1024); } while (0)
#define PG8_LDB(dst, b, h) do { _Pragma("unroll") for (int n = 0; n < 2; ++n) _Pragma("unroll") for (int k = 0; k < 2; ++k) dst[n][k] = *(const PG8_LAS bf16x8*)(lds + PG8_SB(b, h) + boff + n * 2048 + k * 1024); } while (0)
#define PG8_MMA(ai, bj, At, Bt) do { __builtin_amdgcn_s_setprio(1); _Pragma("unroll") for (int m = 0; m < 4; ++m) _Pragma("unroll") for (int n = 0; n < 2; ++n) _Pragma("unroll") for (int k = 0; k < 2; ++k) \
        acc[ai][bj][m][n] = __builtin_amdgcn_mfma_f32_16x16x32_bf16(Bt[n][k], At[m][k], acc[ai][bj][m][n], 0, 0, 0); __builtin_amdgcn_s_setprio(0); } while (0)
#define PG8_WAIT_V(n) asm volatile("s_waitcnt vmcnt(" #n ")" ::: "memory")
#define PG8_WAIT_L(n) asm volatile("s_waitcnt lgkmcnt(" #n ")" ::: "memory")
#define PG8_BAR __builtin_amdgcn_s_barrier()
#define PG8_SCHED __builtin_amdgcn_sched_barrier(0)
    Unit cur, nxt; int ui = 0;
    if (!S.next(0, cur)) return;
    f32x4 acc[2][2][4][2];
#pragma unroll
    for (int a = 0; a < 2; ++a)
#pragma unroll
        for (int b = 0; b < 2; ++b)
#pragma unroll
            for (int m = 0; m < 4; ++m)
#pragma unroll
                for (int n = 0; n < 2; ++n) acc[a][b][m][n] = (f32x4){0.f, 0.f, 0.f, 0.f};
    bf16x8 At[4][2], B0[2][2], B1[2][2];
    const char* cA = (const char*)g.A + (size_t)cur.pm * tstep; const char* cB = (const char*)g.Bt + (size_t)cur.pn * tstep;
    S.a_ready(cur);
    if constexpr (SP2) {
        PG8_STAGE(PG8_SB(0, 0), cB, voffB); PG8_STAGE(PG8_SB(0, 1), cB + hstep, voffB); PG8_STAGE(PG8_SA(0, 0), cA, voffA); PG8_STAGE(PG8_SA(0, 1), cA + hstep, voffA);
        if (wr == 1) PG8_BAR;
        PG8_WAIT_V(2); PG8_BAR;
        PG8_STAGE(PG8_SB(1, 0), cB + kstep, voffB); PG8_STAGE(PG8_SA(1, 0), cA + kstep, voffA); PG8_STAGE(PG8_SB(1, 1), cB + hstep + kstep, voffB);
        PG8_WAIT_V(6); PG8_BAR;
    } else {
        PG8_STAGE(PG8_SB(0, 0), cB, voffB); PG8_STAGE(PG8_SA(0, 0), cA, voffA); PG8_STAGE(PG8_SB(0, 1), cB + hstep, voffB); PG8_STAGE(PG8_SA(0, 1), cA + hstep, voffA);
        if (wr == 1) PG8_BAR;
        PG8_WAIT_V(4); PG8_BAR;
        PG8_STAGE(PG8_SB(1, 0), cB + kstep, voffB); PG8_STAGE(PG8_SA(1, 0), cA + kstep, voffA); PG8_STAGE(PG8_SB(1, 1), cB + hstep + kstep, voffB);
        PG8_WAIT_V(6); PG8_BAR;
    }
    for (;;) {
        const bool has_next = S.next(ui + 1, nxt);
        const char* nA = has_next ? (const char*)g.A + (size_t)nxt.pm * tstep : cA; const char* nB = has_next ? (const char*)g.Bt + (size_t)nxt.pn * tstep : cB;
        for (int t = 0; t < nt; t += 2) {
            const bool last = (t == nt - 2);
            const char* a1 = cA + (size_t)(t + 1) * kstep;
            const char* a2 = last ? nA : cA + (size_t)(t + 2) * kstep; const char* b2 = last ? nB : cB + (size_t)(t + 2) * kstep;
            const char* a3 = a2 + kstep; const char* b3 = b2 + kstep;
            if (last && has_next) S.a_ready(nxt);
            if constexpr (SP2) {
            PG8_LDB(B0, 0, 0); PG8_LDB(B1, 0, 1); PG8_SCHED; PG8_LDA(At, 0, 0); PG8_STAGE(PG8_SA(1, 1), a1 + hstep, voffA);
            PG8_WAIT_V(8); PG8_WAIT_L(0); PG8_BAR; PG8_MMA(0, 0, At, B0); PG8_MMA(0, 1, At, B1); PG8_BAR; PG8_SCHED;
            PG8_LDA(At, 0, 1); PG8_STAGE(PG8_SB(0, 0), b2, voffB); PG8_STAGE(PG8_SB(0, 1), b2 + hstep, voffB); PG8_STAGE(PG8_SA(0, 0), a2, voffA);
            PG8_WAIT_V(8); PG8_WAIT_L(0); PG8_BAR; PG8_MMA(1, 0, At, B0); PG8_MMA(1, 1, At, B1); PG8_BAR; PG8_SCHED;
            PG8_LDB(B0, 1, 0); PG8_LDB(B1, 1, 1); PG8_SCHED; PG8_LDA(At, 1, 0); PG8_STAGE(PG8_SA(0, 1), a2 + hstep, voffA);
            PG8_WAIT_V(8); PG8_WAIT_L(0); PG8_BAR; PG8_MMA(0, 0, At, B0); PG8_MMA(0, 1, At, B1); PG8_BAR; PG8_SCHED;
            PG8_LDA(At, 1, 1); PG8_STAGE(PG8_SB(1, 0), b3, voffB); PG8_STAGE(PG8_SB(1, 1), b3 + hstep, voffB); PG8_STAGE(PG8_SA(1, 0), a3, voffA);
            PG8_WAIT_V(8); PG8_WAIT_L(0); PG8_BAR; PG8_MMA(1, 0, At, B0); PG8_MMA(1, 1, At, B1); PG8_BAR; PG8_SCHED;
            } else {
            PG8_LDB(B0, 0, 0); PG8_SCHED; PG8_LDA(At, 0, 0); PG8_STAGE(PG8_SA(1, 1), a1 + hstep, voffA);
            PG8_WAIT_L(8); PG8_BAR; PG8_WAIT_L(0); PG8_MMA(0, 0, At, B0); PG8_BAR; PG8_SCHED;
            PG8_LDB(B1, 0, 1); PG8_STAGE(PG8_SB(0, 0), b2, voffB);
            PG8_BAR; PG8_WAIT_L(0); PG8_MMA(0, 1, At, B1); PG8_BAR;
            PG8_LDA(At, 0, 1); PG8_STAGE(PG8_SA(0, 0), a2, voffA);
            PG8_BAR; PG8_WAIT_L(0); PG8_MMA(1, 0, At, B0); PG8_BAR; PG8_SCHED;
            PG8_STAGE(PG8_SB(0, 1), b2 + hstep, voffB);
            PG8_WAIT_V(6); PG8_BAR; PG8_MMA(1, 1, At, B1); PG8_BAR;
            PG8_LDB(B0, 1, 0); PG8_SCHED; PG8_LDA(At, 1, 0); PG8_STAGE(PG8_SA(0, 1), a2 + hstep, voffA);
            PG8_WAIT_L(8); PG8_BAR; PG8_WAIT_L(0); PG8_MMA(0, 0, At, B0); PG8_BAR; PG8_SCHED;
            PG8_LDB(B1, 1, 1); PG8_STAGE(PG8_SB(1, 0), b3, voffB);
            PG8_BAR; PG8_WAIT_L(0); PG8_MMA(0, 1, At, B1); PG8_BAR;
            PG8_LDA(At, 1, 1); PG8_STAGE(PG8_SA(1, 0), a3, voffA);
            PG8_BAR; PG8_WAIT_L(0); PG8_MMA(1, 0, At, B0); PG8_BAR; PG8_SCHED;
            PG8_STAGE(PG8_SB(1, 1), b3 + hstep, voffB);
            PG8_WAIT_V(6); PG8_BAR; PG8_MMA(1, 1, At, B1); PG8_BAR;
            }
        }
        if constexpr (ALIGN_EPI) { if (wr == 0) PG8_BAR; }
        if constexpr (!Epi::AFTER_DRAIN) { E(acc, cur, wr, wc, fr, fq); S.done(cur); }
        if (!has_next) break;
#pragma unroll
        for (int a = 0; a < 2; ++a)
#pragma unroll
            for (int b = 0; b < 2; ++b)
#pragma unroll
                for (int m = 0; m < 4; ++m)
#pragma unroll
                    for (int n = 0; n < 2; ++n) acc[a][b][m][n] = (f32x4){0.f, 0.f, 0.f, 0.f};
        cur = nxt; cA = nA; cB = nB; ++ui;
        if constexpr (ALIGN_EPI) { if (wr == 1) PG8_BAR; }
    }
    PG8_WAIT_V(0);
    if constexpr (!ALIGN_EPI) { if (wr == 0) PG8_BAR; }
    PG8_BAR;
    if constexpr (Epi::AFTER_DRAIN) { E.fused(acc, cur, wr, wc, fr, fq, lds, wid, lane); S.done(cur); }
#undef PG8_SA
#undef PG8_SB
#undef PG8_STAGE
#undef PG8_LDA
#undef PG8_LDB
#undef PG8_MMA
#undef PG8_WAIT_V
#undef PG8_WAIT_L
#undef PG8_BAR
#undef PG8_SCHED
}
}

constexpr int NWAVES = 8;
constexpr int DM = 1024, NBATCH = 16, SEQ = 2048, MTOK = NBATCH * SEQ, MROWS = 33024, META_ROW0 = 32768;
constexpr int DFF = 2816, WIN_ROWS = 3328;
constexpr float RMS_EPS = 1e-6f;
constexpr float LOG2E = 1.4426950408889634f;
using pg8::PROJ_P; using pg8::VT_P;
constexpr int PC_NAQ = 0, PC_NAK = 512, PC_GQ = 1024, PC_GK = 1280, PC_GR = 1536;
constexpr size_t WS_XN = 0;
constexpr size_t WS_WIN = WS_XN + (size_t)MROWS * DM * 2;
constexpr size_t WS_WOUT = WS_WIN + (size_t)WIN_ROWS * DM * 2;
constexpr size_t WS_WGU = WS_WOUT + (size_t)DM * DM * 2;
constexpr size_t WS_WDN = WS_WGU + (size_t)2 * DFF * DM * 2;
constexpr size_t WS_SS1 = WS_WDN + (size_t)DM * DFF * 2;
constexpr size_t WS_SS2 = WS_SS1 + (size_t)MTOK * 4;
constexpr size_t WS_CTR = WS_SS2 + (size_t)MTOK * 4;
constexpr size_t WS_GATE = WS_CTR + 256;
constexpr size_t WS_OG = WS_GATE + (size_t)MROWS * 32 * 4;
constexpr size_t WS_MIX = WS_OG + (size_t)2 * MTOK * 512 * 2;
constexpr size_t WS_PROJ = WS_MIX + (size_t)MTOK * DM * 2;
constexpr size_t WS_VT = WS_PROJ + (size_t)MROWS * PROJ_P * 2;
constexpr size_t WS_F = WS_PROJ;
constexpr size_t WS_END = WS_VT + (size_t)1024 * VT_P * 2;
static_assert(WS_F + (size_t)MTOK * DFF * 2 <= WS_END, "F overlay fits");
static_assert(WS_WIN % 16 == 0 && WS_GATE % 16 == 0 && WS_OG % 16 == 0 && WS_PROJ % 16 == 0 && WS_VT % 16 == 0, "alignment");

constexpr int LDS_BYTES = 163840;
#define LAS __attribute__((address_space(3)))
typedef unsigned short bf16;
typedef unsigned v4u __attribute__((ext_vector_type(4)));
typedef unsigned v2u __attribute__((ext_vector_type(2)));
typedef float f32x4 __attribute__((ext_vector_type(4)));
typedef short bf16x8 __attribute__((ext_vector_type(8)));
using pg8::cvtpk;
__device__ __forceinline__ float bf2f(unsigned short x) { return __uint_as_float((unsigned)x << 16); }
#define MFMA16(a, b, c) __builtin_amdgcn_mfma_f32_16x16x32_bf16((a), (b), (c), 0, 0, 0)

__device__ __forceinline__ int my_tid(int) { return (int)threadIdx.x; }
struct Args { const float* in[17]; float* out; unsigned char* ws; int ph_lo, ph_hi; };
typedef const __attribute__((address_space(4))) Args* KArgP;

__device__ __forceinline__ float wave_sum(float v) {
#pragma unroll
    for (int o = 1; o < 64; o <<= 1) v += __shfl_xor(v, o);
    return v;
}

__device__ __forceinline__ void tr_item(const float* W, int N, int k0, int n0, bf16* dst, int Kp, const float* kgain, LAS float* scr, int lane) {
    float tv[32];
#pragma unroll
    for (int i = 0; i < 32; ++i) { const int kk = 2 * i + (lane >> 5); tv[i] = W[(size_t)(k0 + kk) * N + n0 + (lane & 31)]; }
    if (kgain) {
#pragma unroll
        for (int i = 0; i < 32; ++i) tv[i] *= kgain[k0 + 2 * i + (lane >> 5)]; }
#pragma unroll
    for (int i = 0; i < 32; ++i) scr[(2 * i + (lane >> 5)) * 33 + (lane & 31)] = tv[i];
    asm volatile("s_waitcnt lgkmcnt(0)" ::: "memory");
    const int c = lane & 7;
#pragma unroll
    for (int j = 0; j < 4; ++j) { const int n = (lane >> 3) + 8 * j; const LAS float* s = scr + (8 * c) * 33 + n;
        v4u o; o.x = cvtpk(s[0 * 33], s[1 * 33]); o.y = cvtpk(s[2 * 33], s[3 * 33]); o.z = cvtpk(s[4 * 33], s[5 * 33]); o.w = cvtpk(s[6 * 33], s[7 * 33]);
        *(v4u*)(dst + (size_t)n * Kp + k0 + 8 * c) = o; }
    asm volatile("s_waitcnt lgkmcnt(0)" ::: "memory");
}
__device__ __forceinline__ int win_row(int n0) {
    if (n0 < 1024) return n0;
    if (n0 < 1536) return 2304 + (n0 - 1024);
    if (n0 < 1792) return 1024 + (n0 - 1536);
    if (n0 < 2048) return 1280 + (n0 - 1792);
    if (n0 < 2560) return 2816 + (n0 - 2048);
    if (n0 < 3072) return 1536 + (n0 - 2560);
    return 2048 + (n0 - 3072);
}
__device__ __forceinline__ void rms_row_to_bf16(const float* xrow, const float* gain, bf16* orow, int lane) {
    const f32x4* xr = (const f32x4*)xrow + lane; const f32x4* gr = (const f32x4*)gain + lane;
    f32x4 v[4]; float s = 0.f;
#pragma unroll
    for (int j = 0; j < 4; ++j) { v[j] = xr[64 * j]; s += (v[j].x * v[j].x + v[j].y * v[j].y) + (v[j].z * v[j].z + v[j].w * v[j].w); }
    const float rstd = 1.0f / sqrtf(wave_sum(s) * (1.f / DM) + RMS_EPS);
    v2u* o8 = (v2u*)orow + lane;
#pragma unroll
    for (int j = 0; j < 4; ++j) { const f32x4 g = gr[64 * j]; v2u w; w.x = cvtpk(v[j].x * rstd * g.x, v[j].y * rstd * g.y); w.y = cvtpk(v[j].z * rstd * g.z, v[j].w * rstd * g.w); o8[64 * j] = w; }
}
__device__ __forceinline__ void rms_row2_to_bf16(const float* xa, const float* xb, const float* gain, bf16* oa, bf16* ob, int lane) {
    const f32x4* ra = (const f32x4*)xa + lane; const f32x4* rb = (const f32x4*)xb + lane; const f32x4* gr = (const f32x4*)gain + lane;
    f32x4 va[4], vb[4]; float sa = 0.f, sb = 0.f;
#pragma unroll
    for (int j = 0; j < 4; ++j) { va[j] = ra[64 * j]; vb[j] = rb[64 * j]; }
#pragma unroll
    for (int j = 0; j < 4; ++j) { sa += (va[j].x * va[j].x + va[j].y * va[j].y) + (va[j].z * va[j].z + va[j].w * va[j].w); sb += (vb[j].x * vb[j].x + vb[j].y * vb[j].y) + (vb[j].z * vb[j].z + vb[j].w * vb[j].w); }
    const float rsa = 1.0f / sqrtf(wave_sum(sa) * (1.f / DM) + RMS_EPS), rsb = 1.0f / sqrtf(wave_sum(sb) * (1.f / DM) + RMS_EPS);
    v2u* o8a = (v2u*)oa + lane; v2u* o8b = (v2u*)ob + lane;
#pragma unroll
    for (int j = 0; j < 4; ++j) { const f32x4 g = gr[64 * j]; v2u w;
        w.x = cvtpk(va[j].x * rsa * g.x, va[j].y * rsa * g.y); w.y = cvtpk(va[j].z * rsa * g.z, va[j].w * rsa * g.w); o8a[64 * j] = w;
        w.x = cvtpk(vb[j].x * rsb * g.x, vb[j].y * rsb * g.y); w.y = cvtpk(vb[j].z * rsb * g.z, vb[j].w * rsb * g.w); o8b[64 * j] = w; }
}
__device__ __forceinline__ void p0_prologue(const Args& a, LAS unsigned char* lds, int G, const int tid) {
    const int lane = tid & 63, wave = __builtin_amdgcn_readfirstlane(tid >> 6);
    LAS float* scr = (LAS float*)(lds + wave * 16384);
    const int gw = blockIdx.x * NWAVES + wave, NGW = G * NWAVES;
    unsigned char* ws = a.ws;
    bf16* WIN = (bf16*)(ws + WS_WIN); bf16* WOUT = (bf16*)(ws + WS_WOUT); bf16* WGU = (bf16*)(ws + WS_WGU); bf16* WDN = (bf16*)(ws + WS_WDN);
    constexpr int I_IN = 16 * 97, I_OUT = 16 * 32, I_G = 16 * 88, I_D = 44 * 32;
    constexpr int NITEMS = I_IN + I_OUT + 2 * I_G + I_D;
    for (int it = gw; it < NITEMS; it += NGW) {
        int r = it;
        if (r < I_IN) { const int kb = r / 97, nb = r % 97; tr_item(a.in[3], 3104, 64 * kb, 32 * nb, WIN + (size_t)win_row(32 * nb) * DM, DM, nullptr, scr, lane); continue; } r -= I_IN;
        if (r < I_OUT) { const int kb = r / 32, nb = r % 32; tr_item(a.in[11], 1024, 64 * kb, 32 * nb, WOUT + (size_t)(32 * nb) * DM, DM, nullptr, scr, lane); continue; } r -= I_OUT;
        if (r < I_G) { const int kb = r / 88, nb = r % 88; const int n0 = 32 * nb; tr_item(a.in[13], DFF, 64 * kb, n0, WGU + (size_t)((n0 >> 7) * 256 + (n0 & 127)) * DM, DM, a.in[12], scr, lane); continue; } r -= I_G;
        if (r < I_G) { const int kb = r / 88, nb = r % 88; const int n0 = 32 * nb; tr_item(a.in[14], DFF, 64 * kb, n0, WGU + (size_t)((n0 >> 7) * 256 + 128 + (n0 & 127)) * DM, DM, a.in[12], scr, lane); continue; } r -= I_G;
        { const int kb = r / 32, nb = r % 32; tr_item(a.in[15], 1024, 64 * kb, 32 * nb, WDN + (size_t)(32 * nb) * DFF, DFF, nullptr, scr, lane); }
    }
    { const int gt = blockIdx.x * (NWAVES * 64) + tid, NGT = G * NWAVES * 64; const v4u z = {0u, 0u, 0u, 0u};
      v4u* p = (v4u*)(WIN + (size_t)2080 * DM); for (int i = gt; i < 224 * DM * 2 / 16; i += NGT) p[i] = z;
      p = (v4u*)((bf16*)(ws + WS_XN) + (size_t)(META_ROW0 + 16) * DM); for (int i = gt; i < 240 * DM * 2 / 16; i += NGT) p[i] = z;
      p = (v4u*)(ws + WS_SS1); for (int i = gt; i < (2 * MTOK * 4 + 256) / 16; i += NGT) p[i] = z; }
    bf16* XN = (bf16*)(ws + WS_XN);
    for (int m = gw; m < MTOK + 16; m += 2 * NGW) { const int m2 = m + NGW; const bool has2 = m2 < MTOK + 16; const int mm2 = has2 ? m2 : m;
        const float* s1 = m < MTOK ? a.in[0] + (size_t)m * DM : a.in[1] + (size_t)(m - MTOK) * DM; const float* s2 = mm2 < MTOK ? a.in[0] + (size_t)mm2 * DM : a.in[1] + (size_t)(mm2 - MTOK) * DM;
        rms_row2_to_bf16(s1, s2, a.in[2], XN + (size_t)m * DM, XN + (size_t)mm2 * DM, lane); }
}

constexpr int NA_K = 0, NA_KSLOT = 64 * 144, NA_V = 9 * NA_KSLOT, NA_VSLOT = 8192, NA_TAB = NA_V + 9 * NA_VSLOT, NA_MB = NA_TAB + 15 * 64 * 4, NA_ITEM = NA_MB + 64, NA_END = NA_ITEM + 64;
static_assert(NA_END <= LDS_BYTES, "NA LDS");
__device__ __forceinline__ int na_s(int i) { return i < 4 ? 0 : (i > 28 ? 24 : i - 4); }
__device__ __forceinline__ void na_item(int item, const Args& a, LAS unsigned char* lds, const int tid) {
    const int lane = tid & 63, w = __builtin_amdgcn_readfirstlane(tid >> 6), fr = lane & 15, fq = lane >> 4;
    const int half = item & 1, h = (item >> 1) & 7, b = item >> 4;
    const bf16* __restrict__ PROJ = (const bf16*)(a.ws + WS_PROJ); const bf16* __restrict__ VT = (const bf16*)(a.ws + WS_VT); bf16* __restrict__ MIX = (bf16*)(a.ws + WS_MIX);
    LAS float* tab = (LAS float*)(lds + NA_TAB); LAS float* mbt = (LAS float*)(lds + NA_MB);
    for (int i = tid; i < 15 * 64; i += NWAVES * 64) { const int x = i & 63, dr = i >> 6; int dc = x - 16; dc = dc < 0 ? 0 : (dc > 30 ? 30 : dc); tab[i] = LOG2E * a.in[4][(h * 15 + dr) * 31 + dc]; }
    if (tid < 16) mbt[tid] = LOG2E * a.in[5][h * 16 + tid];
    const size_t tokbase = (size_t)b * SEQ;
    const int lrow = tid >> 3, lch = tid & 7;
    const bf16* kg = PROJ + (tokbase + lrow) * PROJ_P + PC_NAK + h * 64 + 8 * lch;
    const bf16* vg = VT + (size_t)(h * 64 + lrow) * VT_P + tokbase + 8 * lch;
    const unsigned kdst = NA_K + lrow * 144 + lch * 16, vdst = NA_V + lrow * 128 + ((lch ^ ((lrow >> 1) & 7)) * 16);
    const int qsel = w >> 2, j = w & 3;
    const int c0 = (j == 0) ? 0 : (j == 1) ? 8 : (j == 2) ? 24 : 32;
    const int cq = 16 * j + fr; const int cs = cq < 8 ? 0 : (cq > 56 ? 48 : cq - 8);
    const int kk0 = 8 * (fr >> 2) + (fr & 3);
    const unsigned kbase = NA_K + (c0 + kk0) * 144 + fq * 16, vbase = NA_V + fr * 128 + ((((c0 >> 3) + fq) ^ (fr >> 1)) * 16);
    const int xb = c0 + 8 * fq - cq + 31; const int elo = cs - c0 - 8 * fq;
    const f32x4 z4 = {0.f, 0.f, 0.f, 0.f};
    const bf16* mp = PROJ + (size_t)(META_ROW0 + fr) * PROJ_P + PC_NAK + h * 64 + 8 * fq;
    const bf16x8 mk0 = *(const bf16x8*)mp, mk1 = *(const bf16x8*)(mp + 32);
    v2u mv[4];
    { const bf16* vm = VT + (size_t)(h * 64 + fr) * VT_P + META_ROW0 + 4 * fq;
#pragma unroll
      for (int dt = 0; dt < 4; ++dt) mv[dt] = *(const v2u*)(vm + (size_t)dt * 16 * VT_P); }
    const float mb0 = 0.f;
    const int i0 = 16 * half;
    { const int lo = na_s(i0), hi = na_s(i0 + 1) + 7;
      v4u kr[9], vr[9];
#pragma unroll
      for (int t = 0; t < 9; ++t) { const int row = lo + t; if (row <= hi) { kr[t] = *(const v4u*)(kg + (size_t)row * 64 * PROJ_P); vr[t] = *(const v4u*)(vg + row * 64); } }
#pragma unroll
      for (int t = 0; t < 9; ++t) { const int row = lo + t; if (row <= hi) { const int slot = row % 9; *(LAS v4u*)(lds + kdst + slot * NA_KSLOT) = kr[t]; *(LAS v4u*)(lds + vdst + slot * NA_VSLOT) = vr[t]; } } }
    __syncthreads();
    for (int pair = 0; pair < 8; ++pair) {
        const int ip = i0 + 2 * pair, i = ip + qsel;
        const int hi = na_s(ip + 1) + 7;
        const int nnew = pair < 7 ? na_s(ip + 3) + 7 - hi : 0;
        v4u nk0, nv0, nk1, nv1;
        if (nnew > 0) { nk0 = *(const v4u*)(kg + (size_t)(hi + 1) * 64 * PROJ_P); nv0 = *(const v4u*)(vg + (hi + 1) * 64); }
        if (nnew > 1) { nk1 = *(const v4u*)(kg + (size_t)(hi + 2) * 64 * PROJ_P); nv1 = *(const v4u*)(vg + (hi + 2) * 64); }
        {
            const int s = na_s(i); const int slot0 = s % 9;
            const bf16* qp = PROJ + (tokbase + i * 64 + cq) * PROJ_P + PC_NAQ + h * 64 + 8 * fq;
            const bf16x8 q0 = *(const bf16x8*)qp, q1 = *(const bf16x8*)(qp + 32);
            float sumv;
            f32x4 sc[8][2];
            { bf16x8 kf[8][4];
#pragma unroll
              for (int r = 0; r < 8; ++r) { int slot = slot0 + r; slot = slot >= 9 ? slot - 9 : slot; const LAS unsigned char* p = lds + kbase + slot * NA_KSLOT;
                  kf[r][0] = *(const LAS bf16x8*)p; kf[r][1] = *(const LAS bf16x8*)(p + 64); kf[r][2] = *(const LAS bf16x8*)(p + 576); kf[r][3] = *(const LAS bf16x8*)(p + 640); }
              __builtin_amdgcn_sched_barrier(0);
              asm volatile("s_waitcnt lgkmcnt(0)" ::: "memory");
#pragma unroll
              for (int r = 0; r < 8; ++r) { sc[r][0] = MFMA16(kf[r][0], q0, z4); sc[r][0] = MFMA16(kf[r][1], q1, sc[r][0]);
                  sc[r][1] = MFMA16(kf[r][2], q0, z4); sc[r][1] = MFMA16(kf[r][3], q1, sc[r][1]); } }
            f32x4 sm = MFMA16(mk0, q0, z4); sm = MFMA16(mk1, q1, sm);
            const float QS = 0.125f * LOG2E;
            float mx = -1e30f;
            { float bt[8][8]; float mbv[4];
#pragma unroll
              for (int r = 0; r < 8; ++r) { const LAS float* tr = tab + (s + r - i + 7) * 64 + xb;
#pragma unroll
                  for (int e = 0; e < 8; ++e) bt[r][e] = tr[e]; }
#pragma unroll
              for (int e = 0; e < 4; ++e) mbv[e] = mbt[4 * fq + e];
              __builtin_amdgcn_sched_barrier(0);
              asm volatile("s_waitcnt lgkmcnt(0)" ::: "memory");
#pragma unroll
              for (int r = 0; r < 8; ++r)
#pragma unroll
                  for (int e = 0; e < 8; ++e) { float v = sc[r][e >> 2][e & 3] * QS + bt[r][e]; const bool ok = (e >= elo) & (e < elo + 16); v = ok ? v : -1e30f; sc[r][e >> 2][e & 3] = v; mx = fmaxf(mx, v); }
#pragma unroll
              for (int e = 0; e < 4; ++e) { const float v = sm[e] * QS + mbv[e]; sm[e] = v; mx = fmaxf(mx, v); } }
            f32x4 o[4] = {z4, z4, z4, z4};
            { bf16x8 vf[4][4];
#pragma unroll
              for (int r = 0; r < 4; ++r) { int slot = slot0 + r; slot = slot >= 9 ? slot - 9 : slot; const LAS unsigned char* p = lds + vbase + slot * NA_VSLOT;
#pragma unroll
                  for (int dt = 0; dt < 4; ++dt) vf[r][dt] = *(const LAS bf16x8*)(p + dt * 2048); }
              __builtin_amdgcn_sched_barrier(0);
              mx = fmaxf(mx, __shfl_xor(mx, 16)); mx = fmaxf(mx, __shfl_xor(mx, 32));
              float sum = 0.f;
#pragma unroll
              for (int r = 0; r < 8; ++r)
#pragma unroll
                  for (int e = 0; e < 8; ++e) { const float p = __builtin_amdgcn_exp2f(sc[r][e >> 2][e & 3] - mx); sc[r][e >> 2][e & 3] = p; sum += p; }
#pragma unroll
              for (int e = 0; e < 4; ++e) { const float p = __builtin_amdgcn_exp2f(sm[e] - mx); sm[e] = p; sum += p; }
              sum += __shfl_xor(sum, 16); sum += __shfl_xor(sum, 32);
              sumv = sum;
              bf16x8 pf[8];
#pragma unroll
              for (int r = 0; r < 8; ++r) pf[r] = __builtin_bit_cast(bf16x8, pg8::pack8(sc[r][0], sc[r][1]));
              asm volatile("s_waitcnt lgkmcnt(0)" ::: "memory");
              bf16x8 vg2[4][4];
#pragma unroll
              for (int r = 0; r < 4; ++r) { int slot = slot0 + 4 + r; slot = slot >= 9 ? slot - 9 : slot; const LAS unsigned char* p = lds + vbase + slot * NA_VSLOT;
#pragma unroll
                  for (int dt = 0; dt < 4; ++dt) vg2[r][dt] = *(const LAS bf16x8*)(p + dt * 2048); }
              __builtin_amdgcn_sched_barrier(0);
#pragma unroll
              for (int r = 0; r < 4; ++r)
#pragma unroll
                  for (int dt = 0; dt < 4; ++dt) o[dt] = MFMA16(vf[r][dt], pf[r], o[dt]);
              asm volatile("s_waitcnt lgkmcnt(0)" ::: "memory");
#pragma unroll
              for (int r = 0; r < 4; ++r)
#pragma unroll
                  for (int dt = 0; dt < 4; ++dt) o[dt] = MFMA16(vg2[r][dt], pf[4 + r], o[dt]); }
            { v4u pw; pw.x = cvtpk(sm[0], sm[1]); pw.y = cvtpk(sm[2], sm[3]); pw.z = 0u; pw.w = 0u; const bf16x8 pf = __builtin_bit_cast(bf16x8, pw);
#pragma unroll
              for (int dt = 0; dt < 4; ++dt) { v4u vw; vw.x = mv[dt].x; vw.y = mv[dt].y; vw.z = 0u; vw.w = 0u; o[dt] = MFMA16(__builtin_bit_cast(bf16x8, vw), pf, o[dt]); } }
            const float inv = 1.0f / sumv;
            bf16* op = MIX + (tokbase + i * 64 + cq) * DM + h * 64 + 4 * fq;
#pragma unroll
            for (int dt = 0; dt < 4; ++dt) { v2u ow; ow.x = cvtpk(o[dt][0] * inv, o[dt][1] * inv); ow.y = cvtpk(o[dt][2] * inv, o[dt][3] * inv); *(v2u*)(op + dt * 16) = ow; }
        }
        __syncthreads();
        if (nnew > 0) { const int slot = (hi + 1) % 9; *(LAS v4u*)(lds + kdst + slot * NA_KSLOT) = nk0; *(LAS v4u*)(lds + vdst + slot * NA_VSLOT) = nv0; }
        if (nnew > 1) { const int slot = (hi + 2) % 9; *(LAS v4u*)(lds + kdst + slot * NA_KSLOT) = nk1; *(LAS v4u*)(lds + vdst + slot * NA_VSLOT) = nv1; }
        __syncthreads();
    }
}

constexpr int GP = 72;
constexpr int G_BUF = 3 * 64 * GP * 2 + 256;
constexpr int G_WUP = 2 * G_BUF, G_END = G_WUP + 17 * 64 * 4;
static_assert(G_END <= LDS_BYTES, "GLA LDS");
template <int dir> __device__ __forceinline__ void gla_item(int item, const Args& a, LAS unsigned char* lds, const int tid) {
    const int lane = tid & 63, w = __builtin_amdgcn_readfirstlane(tid >> 6), fr = lane & 15, fq = lane >> 4;
    const int h = (item >> 1) & 3, b = item >> 3;
    const bf16* __restrict__ PROJ = (const bf16*)(a.ws + WS_PROJ); const bf16* __restrict__ VT = (const bf16*)(a.ws + WS_VT); const float* __restrict__ GATE = (const float*)(a.ws + WS_GATE);
    bf16* OG = (bf16*)(a.ws + WS_OG) + (size_t)dir * MTOK * 512;
    LAS float* WUP = (LAS float*)(lds + G_WUP);
    { const float* W = dir ? a.in[8] : a.in[6]; const float* B = dir ? a.in[9] : a.in[7];
      for (int i = tid; i < 17 * 64; i += NWAVES * 64) { const int r = i >> 6, d = i & 63; WUP[i] = LOG2E * (r < 16 ? W[r * 256 + h * 64 + d] : B[h * 64 + d]); } }
    __syncthreads();
    const f32x4 z4 = {0.f, 0.f, 0.f, 0.f};
    f32x4 st[4] = {z4, z4, z4, z4};
    const int nsteps = dir ? 32 : 33;
    const int kk0 = 8 * (fr >> 2) + (fr & 3);
    const int tk = dir ? 63 - lane : lane;
    v4u q16, k16; f32x4 lowv[4]; bf16x8 vf0, vf1;
#define GLA_LOAD(n_, Q, K, L, V0, V1) do { const int n__ = (n_); const int r0_ = n__ ? b * SEQ + 64 * (n__ - 1) : META_ROW0 - 48; const bool ok_ = n__ || lane >= 48; \
        const bf16* p_ = PROJ + (size_t)(r0_ + tk) * PROJ_P + h * 64 + 8 * w; const float* g_ = GATE + (size_t)(r0_ + tk) * 32 + dir * 16; \
        if (ok_) { Q = *(const v4u*)(p_ + PC_GQ); K = *(const v4u*)(p_ + PC_GK); L[0] = *(const f32x4*)g_; L[1] = *(const f32x4*)(g_ + 4); L[2] = *(const f32x4*)(g_ + 8); L[3] = *(const f32x4*)(g_ + 12); } \
        else { Q = (v4u){0u, 0u, 0u, 0u}; K = Q; L[0] = z4; L[1] = z4; L[2] = z4; L[3] = z4; } \
        const bf16* v_ = VT + (size_t)(512 + h * 128 + 16 * w + fr) * VT_P + r0_ + 8 * fq; V0 = *(const bf16x8*)v_; V1 = *(const bf16x8*)(v_ + 32); } while (0)
    GLA_LOAD(dir ? 32 : 0, q16, k16, lowv, vf0, vf1);
    for (int step = 0; step < nsteps; ++step) {
        const int n = dir ? 32 - step : step;
        const int row0 = n ? b * SEQ + 64 * (n - 1) : META_ROW0 - 48;
        const bool tok_ok = n || lane >= 48;
        LAS unsigned char* buf = lds + (step & 1) * G_BUF;
        LAS bf16* QE = (LAS bf16*)buf; LAS bf16* KE = QE + 64 * GP; LAS bf16* KDT = KE + 64 * GP; LAS float* DEC = (LAS float*)(buf + 3 * 64 * GP * 2);
        v4u nq16 = q16, nk16 = k16; f32x4 nlow[4] = {z4, z4, z4, z4}; bf16x8 nvf0 = vf0, nvf1 = vf1;
        if (step + 1 < nsteps) GLA_LOAD(dir ? 31 - step : step + 1, nq16, nk16, nlow, nvf0, nvf1);
        float g[8], tot[8];
        { const LAS f32x4* bp = (const LAS f32x4*)(WUP + 16 * 64 + 8 * w); const f32x4 b0 = bp[0], b1 = bp[1];
#pragma unroll
          for (int j = 0; j < 4; ++j) { g[j] = b0[j]; g[4 + j] = b1[j]; }
#pragma unroll
          for (int rb = 0; rb < 2; ++rb) { f32x4 wa[8], wb[8];
#pragma unroll
              for (int r = 0; r < 8; ++r) { const LAS f32x4* wp = (const LAS f32x4*)(WUP + (8 * rb + r) * 64 + 8 * w); wa[r] = wp[0]; wb[r] = wp[1]; }
              __builtin_amdgcn_sched_barrier(0);
              asm volatile("s_waitcnt lgkmcnt(0)" ::: "memory");
#pragma unroll
              for (int r = 0; r < 8; ++r) { const float l = lowv[(8 * rb + r) >> 2][(8 * rb + r) & 3];
#pragma unroll
                  for (int j = 0; j < 4; ++j) { g[j] += l * wa[r][j]; g[4 + j] += l * wb[r][j]; } } }
#pragma unroll
          for (int j = 0; j < 8; ++j) { const float z = g[j]; float v = (fminf(z, 0.f) - __builtin_amdgcn_logf(1.0f + __builtin_amdgcn_exp2f(-fabsf(z)))) * (1.0f / 16.0f); g[j] = tok_ok ? v : 0.f; } }
#define DPP_SHR(v, n) __builtin_bit_cast(float, __builtin_amdgcn_update_dpp(0, __builtin_bit_cast(int, (v)), 0x110 + (n), 0xf, 0xf, true))
#pragma unroll
        for (int j = 0; j < 8; ++j) { float v = g[j];
            v += DPP_SHR(v, 1); v += DPP_SHR(v, 2); v += DPP_SHR(v, 4); v += DPP_SHR(v, 8);
            const int vi = __builtin_bit_cast(int, v);
            const float r0 = __builtin_bit_cast(float, __builtin_amdgcn_readlane(vi, 15)), r1 = __builtin_bit_cast(float, __builtin_amdgcn_readlane(vi, 31)), r2 = __builtin_bit_cast(float, __builtin_amdgcn_readlane(vi, 47)), r3 = __builtin_bit_cast(float, __builtin_amdgcn_readlane(vi, 63));
            v += (lane >= 16 ? r0 : 0.f) + (lane >= 32 ? r1 : 0.f) + (lane >= 48 ? r2 : 0.f);
            g[j] = v; tot[j] = (r0 + r1) + (r2 + r3); }
#undef DPP_SHR
        { unsigned qw[4], kw[4];
#pragma unroll
          for (int j2 = 0; j2 < 4; ++j2) { float qe[2], ke[2];
#pragma unroll
              for (int x = 0; x < 2; ++x) { const int j = 2 * j2 + x;
                  const float eb = __builtin_amdgcn_exp2f(g[j]), enb = __builtin_amdgcn_rcpf(eb), dec = __builtin_amdgcn_exp2f(tot[j]);
                  const unsigned qraw = q16[j2], kraw = k16[j2];
                  const float qf = x ? __uint_as_float(qraw & 0xffff0000u) : __uint_as_float(qraw << 16), kf = x ? __uint_as_float(kraw & 0xffff0000u) : __uint_as_float(kraw << 16);
                  qe[x] = qf * 0.125f * eb; ke[x] = kf * enb;
                  KDT[(8 * w + j) * GP + tk] = (bf16)(cvtpk(ke[x] * dec, 0.f) & 0xffffu); }
              qw[j2] = cvtpk(qe[0], qe[1]); kw[j2] = cvtpk(ke[0], ke[1]); }
          *(LAS v4u*)(QE + tk * GP + 8 * w) = (v4u){qw[0], qw[1], qw[2], qw[3]};
          *(LAS v4u*)(KE + tk * GP + 8 * w) = (v4u){kw[0], kw[1], kw[2], kw[3]};
          float dsel = tot[0];
#pragma unroll
          for (int j = 1; j < 8; ++j) dsel = lane == j ? tot[j] : dsel;
          if (lane < 8) DEC[8 * w + lane] = __builtin_amdgcn_exp2f(dsel); }
        __syncthreads();
        bf16x8 keF[2][2][2], kdF[4][2]; f32x4 dcv[4];
#pragma unroll
        for (int kg = 0; kg < 2; ++kg)
#pragma unroll
            for (int t = 0; t < 2; ++t)
#pragma unroll
                for (int dks = 0; dks < 2; ++dks) keF[kg][t][dks] = *(const LAS bf16x8*)(KE + (32 * kg + kk0 + 4 * t) * GP + 32 * dks + 8 * fq);
        const bf16x8 sf0 = __builtin_bit_cast(bf16x8, pg8::pack8(st[0], st[1])), sf1 = __builtin_bit_cast(bf16x8, pg8::pack8(st[2], st[3]));
#pragma unroll
        for (int qh = 0; qh < 2; ++qh) {
            bf16x8 yq[2][2]; v2u ypr[2][4];
#pragma unroll
            for (int q2 = 0; q2 < 2; ++q2) { const LAS bf16* qrow = QE + (16 * (2 * qh + q2) + fr) * GP;
#pragma unroll
                for (int dks = 0; dks < 2; ++dks) yq[q2][dks] = *(const LAS bf16x8*)(qrow + 32 * dks + 8 * fq);
#pragma unroll
                for (int c = 0; c < 4; ++c) ypr[q2][c] = *(const LAS v2u*)(qrow + 16 * c + 4 * fq); }
            if (qh == 1) {
#pragma unroll
                for (int dkt = 0; dkt < 4; ++dkt) { kdF[dkt][0] = *(const LAS bf16x8*)(KDT + (16 * dkt + fr) * GP + 8 * fq); kdF[dkt][1] = *(const LAS bf16x8*)(KDT + (16 * dkt + fr) * GP + 32 + 8 * fq); dcv[dkt] = *(const LAS f32x4*)(DEC + 16 * dkt + 4 * fq); } }
            __builtin_amdgcn_sched_barrier(0);
            asm volatile("s_waitcnt lgkmcnt(0)" ::: "memory");
            if (n) {
#pragma unroll
                for (int q2 = 0; q2 < 2; ++q2) { const int qt = 2 * qh + q2; f32x4 o = z4;
#pragma unroll
                    for (int kg = 0; kg < 2; ++kg) {
                        const bool need = dir ? (kg == 1 || qt < 2) : (kg == 0 || qt >= 2);
                        if (need) {
                            f32x4 s0 = MFMA16(keF[kg][0][0], yq[q2][0], z4); s0 = MFMA16(keF[kg][0][1], yq[q2][1], s0);
                            f32x4 s1 = MFMA16(keF[kg][1][0], yq[q2][0], z4); s1 = MFMA16(keF[kg][1][1], yq[q2][1], s1);
                            const int qi = 16 * qt + fr, kb = 32 * kg + 8 * fq;
#pragma unroll
                            for (int e = 0; e < 4; ++e) { const bool k0 = dir ? (kb + e >= qi) : (kb + e <= qi); const bool k1 = dir ? (kb + 4 + e >= qi) : (kb + 4 + e <= qi); s0[e] = k0 ? s0[e] : 0.f; s1[e] = k1 ? s1[e] : 0.f; }
                            const bf16x8 pf = __builtin_bit_cast(bf16x8, pg8::pack8(s0, s1));
                            o = MFMA16(kg ? vf1 : vf0, pf, o);
                        }
                    }
                    const v4u y0 = {ypr[q2][0].x, ypr[q2][0].y, ypr[q2][1].x, ypr[q2][1].y}, y1 = {ypr[q2][2].x, ypr[q2][2].y, ypr[q2][3].x, ypr[q2][3].y};
                    o = MFMA16(sf0, __builtin_bit_cast(bf16x8, y0), o); o = MFMA16(sf1, __builtin_bit_cast(bf16x8, y1), o);
                    v2u ow; ow.x = cvtpk(o[0], o[1]); ow.y = cvtpk(o[2], o[3]);
                    *(v2u*)(OG + (size_t)(row0 + 16 * qt + fr) * 512 + h * 128 + 16 * w + 4 * fq) = ow;
                }
            }
        }
#pragma unroll
        for (int dkt = 0; dkt < 4; ++dkt) { st[dkt] = st[dkt] * dcv[dkt];
            st[dkt] = MFMA16(kdF[dkt][0], vf0, st[dkt]); st[dkt] = MFMA16(kdF[dkt][1], vf1, st[dkt]); }
        q16 = nq16; k16 = nk16; vf0 = nvf0; vf1 = nvf1;
#pragma unroll
        for (int r = 0; r < 4; ++r) lowv[r] = nlow[r];
    }
#undef GLA_LOAD
    __syncthreads();
}

__device__ __forceinline__ void gla_combine(const Args& a, int G, const int tid) {
    const int lane = tid & 63, wave = tid >> 6, sub = lane >> 4, l = lane & 15;
    const bf16* OG0 = (const bf16*)(a.ws + WS_OG); const bf16* OG1 = OG0 + (size_t)MTOK * 512; const bf16* PROJ = (const bf16*)(a.ws + WS_PROJ); bf16* MIX = (bf16*)(a.ws + WS_MIX);
    const float* gain = a.in[10];
    const int gw = blockIdx.x * NWAVES + wave, NGW = G * NWAVES;
    float gn[8];
#pragma unroll
    for (int e = 0; e < 8; ++e) gn[e] = gain[8 * l + e];
    for (int pr = gw * 4 + sub; pr < MTOK * 4; pr += NGW * 4) {
        const int tok = pr >> 2, h = pr & 3;
        const v4u f = *(const v4u*)(OG0 + (size_t)tok * 512 + h * 128 + 8 * l), bw = *(const v4u*)(OG1 + (size_t)tok * 512 + h * 128 + 8 * l), rr = *(const v4u*)(PROJ + (size_t)tok * PROJ_P + PC_GR + h * 128 + 8 * l);
        float o[8], rv[8]; float ss = 0.f;
#pragma unroll
        for (int e = 0; e < 4; ++e) { const unsigned fw = f[e], bwv = bw[e], rw = rr[e];
            o[2 * e] = __uint_as_float(fw << 16) + __uint_as_float(bwv << 16); o[2 * e + 1] = __uint_as_float(fw & 0xffff0000u) + __uint_as_float(bwv & 0xffff0000u);
            rv[2 * e] = __uint_as_float(rw << 16); rv[2 * e + 1] = __uint_as_float(rw & 0xffff0000u); }
#pragma unroll
        for (int e = 0; e < 8; ++e) ss += o[e] * o[e];
        ss += __shfl_xor(ss, 1); ss += __shfl_xor(ss, 2); ss += __shfl_xor(ss, 4); ss += __shfl_xor(ss, 8);
        const float rstd = 1.0f / sqrtf(ss * (1.0f / 128.0f) + RMS_EPS);
        float y[8];
#pragma unroll
        for (int e = 0; e < 8; ++e) { const float r = rv[e]; y[e] = o[e] * rstd * gn[e] * (r / (1.0f + __expf(-r))); }
        v4u ow; ow.x = cvtpk(y[0], y[1]); ow.y = cvtpk(y[2], y[3]); ow.z = cvtpk(y[4], y[5]); ow.w = cvtpk(y[6], y[7]);
        *(v4u*)(MIX + (size_t)tok * DM + 512 + h * 128 + 8 * l) = ow;
    }
}

__device__ __forceinline__ void final_norm(const Args& a, int G, const int tid) {
    const int lane = tid & 63, wave = tid >> 6;
    const float* SS2 = (const float*)(a.ws + WS_SS2); const f32x4* gr = (const f32x4*)a.in[16] + lane;
    f32x4 g[4];
#pragma unroll
    for (int j = 0; j < 4; ++j) g[j] = gr[64 * j];
    const int gw = blockIdx.x * NWAVES + wave, NGW = G * NWAVES;
    for (int m = gw; m < MTOK; m += NGW) { const float rstd = 1.0f / sqrtf(SS2[m] * (1.0f / DM) + RMS_EPS); f32x4* p = (f32x4*)(a.out + (size_t)m * DM) + lane;
#pragma unroll
        for (int j = 0; j < 4; ++j) { f32x4 v = p[64 * j]; v = v * rstd * g[j]; p[64 * j] = v; } }
}

constexpr int NPHASE = 8;
__global__ void __launch_bounds__(NWAVES * 64, 2) mega_fwd(Args args) {
    extern __shared__ __attribute__((aligned(16))) unsigned char lds_raw[];
    LAS unsigned char* lds = (LAS unsigned char*)lds_raw;
    cg::grid_group grid = cg::this_grid();
    const int G = gridDim.x;
    const int wave_s = 0; (void)wave_s;
    const int lo = args.ph_lo, hi = args.ph_hi;
#define IN(k) (lo <= (k) && (k) < hi)
#if defined(__HIP_DEVICE_COMPILE__)
#define PHASE_ARGS() KArgP kap_ = (KArgP)__builtin_amdgcn_kernarg_segment_ptr(); asm volatile("" : "+s"(kap_)); const Args A = *kap_; unsigned char* ws = A.ws; (void)ws
#else
#define PHASE_ARGS() const Args A = args; unsigned char* ws = A.ws; (void)ws
#endif
#define SEAM(k) do { if (IN(k) && IN((k) + 1)) grid.sync(); } while (0)
    if (IN(0)) { PHASE_ARGS(); p0_prologue(A, lds, G, my_tid(wave_s)); } SEAM(0);
    if (IN(1)) {
        PHASE_ARGS();
        pg8::Gemm g{(const pg8::bf16_t*)(ws + WS_XN), (const pg8::bf16_t*)(ws + WS_XN), MROWS + WIN_ROWS, MROWS + WIN_ROWS, DM};
        pg8::SchedP1 S; S.init(G, (int)blockIdx.x);
        pg8::EpiProj E{(pg8::bf16_t*)(ws + WS_PROJ), (float*)(ws + WS_GATE), (pg8::bf16_t*)(ws + WS_VT)};
        pg8::gemm_phase<pg8::EpiProj, pg8::SchedP1, true, true>(lds, g, S, E, my_tid(wave_s));
    } SEAM(1);
    if (IN(2)) {
        PHASE_ARGS(); const int tid2 = my_tid(wave_s);
        if (blockIdx.x < 128) { if (blockIdx.x & 1) gla_item<1>((int)blockIdx.x, A, lds, tid2); else gla_item<0>((int)blockIdx.x, A, lds, tid2); }
        unsigned* ctr = (unsigned*)(ws + WS_CTR);
        for (;;) {
            if (tid2 == 0) *(LAS unsigned*)(lds + NA_ITEM) = atomicAdd(ctr, 1u);
            __syncthreads();
            const unsigned it = (unsigned)__builtin_amdgcn_readfirstlane((int)*(LAS unsigned*)(lds + NA_ITEM));
            __syncthreads();
            if (it >= 256u) break;
            na_item((int)it, A, lds, tid2);
        }
    } SEAM(2);
    if (IN(3)) { PHASE_ARGS(); gla_combine(A, G, my_tid(wave_s)); } SEAM(3);
    if (IN(4)) {
        PHASE_ARGS();
        pg8::Gemm g{(const pg8::bf16_t*)(ws + WS_MIX), (const pg8::bf16_t*)(ws + WS_WOUT), MTOK, DM, DM};
        pg8::StaticOrder S; S.init(MTOK, DM, G, (int)blockIdx.x);
        pg8::EpiRes1 E{A.in[0], A.out, (pg8::bf16_t*)(ws + WS_XN), (float*)(ws + WS_SS1)};
        pg8::gemm_phase<pg8::EpiRes1, pg8::StaticOrder, true, true>(lds, g, S, E, my_tid(wave_s));
    } SEAM(4);
    if (IN(5)) {
        PHASE_ARGS();
        pg8::Gemm g{(const pg8::bf16_t*)(ws + WS_XN), (const pg8::bf16_t*)(ws + WS_WGU), MTOK, 2 * DFF, DM};
        pg8::StaticOrder S; S.init(MTOK, 2 * DFF, G, (int)blockIdx.x);
        pg8::EpiSwiglu E{(pg8::bf16_t*)(ws + WS_F), (const float*)(ws + WS_SS1)};
        pg8::gemm_phase<pg8::EpiSwiglu, pg8::StaticOrder, true, true>(lds, g, S, E, my_tid(wave_s));
    } SEAM(5);
    if (IN(6)) {
        PHASE_ARGS();
        pg8::Gemm g{(const pg8::bf16_t*)(ws + WS_F), (const pg8::bf16_t*)(ws + WS_WDN), MTOK, DM, DFF};
        pg8::StaticOrder S; S.init(MTOK, DM, G, (int)blockIdx.x);
        pg8::EpiRes2 E{A.out, (float*)(ws + WS_SS2)};
        pg8::gemm_phase<pg8::EpiRes2, pg8::StaticOrder, true, true>(lds, g, S, E, my_tid(wave_s));
    } SEAM(6);
    if (IN(7)) { PHASE_ARGS(); final_norm(A, G, my_tid(wave_s)); }
#undef IN
#undef SEAM
#undef PHASE_ARGS
}

extern "C" void kernel_launch(void* const* d_in, const int* in_sizes, int n_in, void* d_out, int out_size, void* d_ws, size_t ws_size, hipStream_t stream) {
    static int grid = 0;
    if (grid == 0) {
        if (n_in != 17 || in_sizes[0] != MTOK * DM || out_size != MTOK * DM || ws_size < WS_END) { fprintf(stderr, "kernel_launch: unexpected shapes (n_in %d, in0 %d, out %d, ws %zu need %zu)\n", n_in, n_in > 0 ? in_sizes[0] : -1, out_size, ws_size, (size_t)WS_END); grid = -1; return; }
        int dev = 0, cus = 0, per_cu = 0;
        hipGetDevice(&dev); hipDeviceGetAttribute(&cus, hipDeviceAttributeMultiprocessorCount, dev);
        if (hipFuncSetAttribute((const void*)mega_fwd, hipFuncAttributeMaxDynamicSharedMemorySize, LDS_BYTES) != hipSuccess) { fprintf(stderr, "kernel_launch: hipFuncSetAttribute failed\n"); grid = -1; return; }
        if (hipOccupancyMaxActiveBlocksPerMultiprocessor(&per_cu, (const void*)mega_fwd, NWAVES * 64, LDS_BYTES) != hipSuccess || per_cu < 1) { fprintf(stderr, "kernel_launch: occupancy query says %d\n", per_cu); per_cu = 1; }
        (void)hipGetLastError();
        grid = cus;
        if (grid > 256) grid = 256;
    }
    if (grid < 0) return;
    Args a{};
    for (int i = 0; i < 17; ++i) a.in[i] = (const float*)d_in[i];
    a.out = (float*)d_out; a.ws = (unsigned char*)d_ws;
#if MK_N_LAUNCHES == 1
    a.ph_lo = 0; a.ph_hi = NPHASE;
    void* kargs[] = {&a};
    hipError_t e = hipLaunchCooperativeKernel((const void*)mega_fwd, dim3(grid), dim3(NWAVES * 64), kargs, LDS_BYTES, stream);
    if (e != hipSuccess) fprintf(stderr, "cooperative launch failed: %s (grid %d)\n", hipGetErrorString(e), grid);
#else
    for (int p = 0; p < NPHASE; ++p) { a.ph_lo = p; a.ph_hi = p + 1; hipLaunchKernelGGL(mega_fwd, dim3(grid), dim3(NWAVES * 64), LDS_BYTES, stream, a); }
#endif
}
```
